# Optimizing an MI355X kernel written in HIP

```python
import jax, jax.numpy as jnp
from jax import lax
import numpy as np

D_MODEL = 1024
BATCH = 4
SEQ = 4096
DEPTH = 2

GRID_W = 64
CTX_LEN = 256
NORM_EPS = 1e-6
N_MOD = 6

MLA_HEADS = 8
MLA_NOPE = 64
MLA_ROPE = 32
MLA_V = 64
Q_RANK = 256
KV_RANK = 128
ROPE_BASE = 10000.0
Q_BLOCK = 128

RWKV_HEADS = 8
RWKV_HEAD = 64
RWKV_WIDTH = RWKV_HEADS * RWKV_HEAD
DECAY_LORA = 64
ICLR_LORA = 64
GATE_LORA = 160
N_DIR = 2
LNX_EPS = 64e-5

MLA_WIDTH = MLA_HEADS * MLA_V
MIX_WIDTH = MLA_WIDTH + RWKV_WIDTH

MLA_COLS = Q_RANK + KV_RANK + MLA_ROPE
RWKV_COLS = 3 * RWKV_WIDTH + N_DIR * DECAY_LORA + N_DIR * ICLR_LORA + GATE_LORA
IN_COLS = MLA_COLS + RWKV_COLS
RWKV_SPLITS = (RWKV_WIDTH, 2 * RWKV_WIDTH, 3 * RWKV_WIDTH,
               3 * RWKV_WIDTH + N_DIR * DECAY_LORA,
               3 * RWKV_WIDTH + N_DIR * (DECAY_LORA + ICLR_LORA))

N_EXPERTS = 16
N_GROUPS = 4
EXPERTS_PER_GROUP = N_EXPERTS // N_GROUPS
TOP_K = 2
EXPERT_HIDDEN = 256
SHARED_HIDDEN = 256

kernel_name = 'hybrid_mla_rwkv7_grouped_moe_dit'


def rmsnorm(x, g):
    xf = x.astype(jnp.float32)
    y = xf * lax.rsqrt(jnp.mean(xf * xf, axis=-1, keepdims=True) + NORM_EPS)
    return (y * g.astype(jnp.float32)).astype(x.dtype)


def modulate(h, shift, scale):
    return h * (1 + scale[:, None, :]) + shift[:, None, :]


def axial_rope_tables(rows):
    row = jnp.repeat(jnp.arange(rows, dtype=jnp.float32), GRID_W)
    col = jnp.tile(jnp.arange(GRID_W, dtype=jnp.float32), rows)
    axis_dim = MLA_ROPE // 2
    inv_freq = ROPE_BASE ** (-jnp.arange(0, axis_dim, 2, dtype=jnp.float32) / axis_dim)
    ang = jnp.concatenate([row[:, None] * inv_freq, col[:, None] * inv_freq], axis=-1)
    return jnp.cos(ang), jnp.sin(ang)


def apply_rope(x, cos, sin):
    half = x.shape[-1] // 2
    x1, x2 = x[..., :half], x[..., half:]
    c = cos[None, :, None, :].astype(x.dtype)
    s = sin[None, :, None, :].astype(x.dtype)
    return jnp.concatenate([x1 * c - x2 * s, x1 * s + x2 * c], axis=-1)


def mla_qkv(p, q_norm_g, kv_norm_g, w_uq, w_ukv, rope):
    b, t, _ = p.shape
    c_q = p[..., :Q_RANK]
    c_kv = p[..., Q_RANK:Q_RANK + KV_RANK]
    k_rope = p[..., Q_RANK + KV_RANK:MLA_COLS][:, :, None, :]
    q = (rmsnorm(c_q, q_norm_g) @ w_uq).reshape(b, t, MLA_HEADS, MLA_NOPE + MLA_ROPE)
    kv = (rmsnorm(c_kv, kv_norm_g) @ w_ukv).reshape(b, t, MLA_HEADS, MLA_NOPE + MLA_V)
    q_nope, q_rope = q[..., :MLA_NOPE], q[..., MLA_NOPE:]
    k_nope, v = kv[..., :MLA_NOPE], kv[..., MLA_NOPE:]
    if rope is not None:
        q_rope = apply_rope(q_rope, *rope)
        k_rope = apply_rope(k_rope, *rope)
    q = jnp.concatenate([q_nope, q_rope], axis=-1)
    k = jnp.concatenate([k_nope, jnp.broadcast_to(k_rope, (b, t, MLA_HEADS, MLA_ROPE))], axis=-1)
    return q, k, v


def blocked_attention(q, k, v):
    b, t, h, dq = q.shape
    scale = dq ** -0.5
    qb = q.reshape(b, t // Q_BLOCK, Q_BLOCK, h, dq).transpose(1, 0, 2, 3, 4)

    def one_block(q_blk):
        s = jnp.einsum('bqhd,bkhd->bhqk', q_blk, k).astype(jnp.float32) * scale
        p = jax.nn.softmax(s, axis=-1).astype(v.dtype)
        return jnp.einsum('bhqk,bkhd->bqhd', p, v)

    out = lax.map(one_block, qb)
    return out.transpose(1, 0, 2, 3, 4).reshape(b, t, h * v.shape[-1])


def centred_token_shift(p, mu):
    prev = jnp.pad(p, ((0, 0), (1, 0), (0, 0)))[:, :-1]
    nxt = jnp.pad(p, ((0, 0), (0, 1), (0, 0)))[:, 1:]
    return p + mu[0] * (prev - p) + mu[1] * (nxt - p)


def rwkv_prepare(p, shift_mu, w0, w2, a0, a2, g2, k_k, k_a):
    b, t, _ = p.shape
    p = centred_token_shift(p, shift_mu)
    r, k, v, wl, al, gl = jnp.split(p, RWKV_SPLITS, axis=-1)
    heads = lambda z: z.reshape(*z.shape[:-1], RWKV_HEADS, RWKV_HEAD)
    g = jax.nn.sigmoid(gl) @ g2
    wl = wl.reshape(b, t, N_DIR, DECAY_LORA)
    al = al.reshape(b, t, N_DIR, ICLR_LORA)
    z = (w0 + jnp.einsum('btdr,drc->btdc', jnp.tanh(wl), w2)).astype(jnp.float32)
    decay = jnp.exp(-jnp.exp(-jax.nn.softplus(-z) - 0.5))
    a = jax.nn.sigmoid(a0 + jnp.einsum('btdr,drc->btdc', al, a2))
    kk = heads(k * k_k).astype(jnp.float32)
    kk = kk * lax.rsqrt(jnp.sum(kk * kk, axis=-1, keepdims=True) + 1e-12)
    k_eff = k[:, :, None, :] * (1 + (a - 1) * k_a)
    return heads(r), heads(v), kk, heads(k_eff), heads(decay), heads(a), g


def rwkv7_scan(state0, r, decay, k, v, kk, a, reverse):
    def step(S, inp):
        r_t, w_t, k_t, v_t, kk_t, a_t = inp
        s_kk = jnp.einsum('bhvk,bhk->bhv', S, kk_t)
        S = (S * w_t[:, :, None, :]
             - s_kk[..., None] * (kk_t * a_t)[:, :, None, :]
             + v_t[..., None] * k_t[:, :, None, :])
        return S, jnp.einsum('bhvk,bhk->bhv', S, r_t)

    xs = tuple(jnp.moveaxis(z.astype(jnp.float32), 1, 0) for z in (r, decay, k, v, kk, a))
    s_last, ys = lax.scan(step, state0, xs, reverse=reverse)
    return jnp.moveaxis(ys, 0, 1), s_last


def rwkv_output(y, r, v, k_eff, g, r_k, lnx_g, lnx_b):
    b, t = y.shape[:2]
    mu = jnp.mean(y, axis=-1, keepdims=True)
    var = jnp.mean(jnp.square(y - mu), axis=-1, keepdims=True)
    yn = ((y - mu) * lax.rsqrt(var + LNX_EPS)).reshape(b, t, RWKV_WIDTH) * lnx_g + lnx_b
    bonus = jnp.sum(r[:, :, None] * k_eff * r_k, axis=(2, 4))
    bonus = (bonus[..., None] * v).reshape(b, t, RWKV_WIDTH)
    return ((yn + bonus) * g).astype(g.dtype)


def rwkv_time_mix(p_lat, p_ctx, shift_mu, w0, w2, a0, a2, g2, k_k, k_a, r_k, lnx_g, lnx_b, ctx_out):
    lat = rwkv_prepare(p_lat, shift_mu, w0, w2, a0, a2, g2, k_k, k_a)
    ctx = rwkv_prepare(p_ctx, shift_mu, w0, w2, a0, a2, g2, k_k, k_a)
    s0 = jnp.zeros((p_lat.shape[0], RWKV_HEADS, RWKV_HEAD, RWKV_HEAD), jnp.float32)

    def scan_dir(prep, d, state0, reverse):
        r, v, kk, k_eff, decay, a, _ = prep
        return rwkv7_scan(state0, r, decay[:, :, d], k_eff[:, :, d], v, kk, a[:, :, d], reverse)

    ys_lat, ys_ctx = [], []
    for d, reverse in enumerate((False, True)):
        y_c, s_ctx = scan_dir(ctx, d, s0, reverse)
        y_l, _ = scan_dir(lat, d, s_ctx, reverse)
        ys_ctx.append(y_c)
        ys_lat.append(y_l)
    out_lat = rwkv_output(ys_lat[0] + ys_lat[1], lat[0], lat[1], lat[3], lat[6], r_k, lnx_g, lnx_b)
    if not ctx_out:
        return out_lat, None
    out_ctx = rwkv_output(ys_ctx[0] + ys_ctx[1], ctx[0], ctx[1], ctx[3], ctx[6], r_k, lnx_g, lnx_b)
    return out_lat, out_ctx


def parallel_mixer(h, hc, rope, w_in, q_norm_g, kv_norm_g, w_uq, w_ukv, shift_mu, w0, w2, a0, a2,
                   g2, k_k, k_a, r_k, lnx_g, lnx_b, w_out, ctx_out):
    p = h @ w_in
    pc = hc @ w_in
    q, k, v = mla_qkv(p[..., :MLA_COLS], q_norm_g, kv_norm_g, w_uq, w_ukv, rope)
    qc, kc, vc = mla_qkv(pc[..., :MLA_COLS], q_norm_g, kv_norm_g, w_uq, w_ukv, None)
    att = blocked_attention(q, jnp.concatenate([k, kc], axis=1), jnp.concatenate([v, vc], axis=1))
    rw, rwc = rwkv_time_mix(p[..., MLA_COLS:], pc[..., MLA_COLS:], shift_mu, w0, w2, a0, a2, g2,
                            k_k, k_a, r_k, lnx_g, lnx_b, ctx_out)
    y = jnp.concatenate([att, rw], axis=-1) @ w_out
    if not ctx_out:
        return y, None
    att_c = blocked_attention(qc, kc, vc)
    yc = jnp.concatenate([att_c, rwc], axis=-1) @ w_out
    return y, yc


def route_shared(h, router_w, router_bias):
    scores = jax.nn.sigmoid((h @ router_w).astype(jnp.float32))
    biased = scores + router_bias.astype(jnp.float32)
    grouped = biased.reshape(*biased.shape[:-1], N_GROUPS, EXPERTS_PER_GROUP)
    group_score = jnp.sum(lax.top_k(grouped, TOP_K)[0], axis=-1)
    best_group = jnp.argmax(group_score, axis=-1)
    expert_group = jnp.arange(N_EXPERTS) // EXPERTS_PER_GROUP
    masked = jnp.where(expert_group == best_group[..., None], biased, -jnp.inf)
    _, idx = lax.top_k(masked, TOP_K)
    w = jnp.take_along_axis(scores, idx, axis=-1)
    w = w / jnp.sum(w, axis=-1, keepdims=True)
    gates = jnp.sum(jax.nn.one_hot(idx, N_EXPERTS, dtype=jnp.float32) * w[..., None], axis=-2)
    return gates.astype(h.dtype)


def swiglu(h, wg, wu, wd):
    return (jax.nn.silu(h @ wg) * (h @ wu)) @ wd


def grouped_moe(h, router_w, router_bias, e_gate, e_up, e_down, s_gate, s_up, s_down):
    gates = route_shared(h, router_w, router_bias)
    out = swiglu(h, s_gate, s_up, s_down)
    for e in range(N_EXPERTS):
        out = out + gates[..., e:e + 1] * swiglu(h, e_gate[e], e_up[e], e_down[e])
    return out


def setup_inputs(seed: int = 0) -> dict:
    key = jax.random.key(seed)
    ks = iter(jax.random.split(key, 48))
    nrm = lambda shape, s: jax.random.normal(next(ks), shape, jnp.float32) * s
    gain = lambda shape: 1.0 + nrm(shape, 0.1)
    L, D = DEPTH, D_MODEL
    return {
        'x': nrm((BATCH, SEQ, D), 1.0),
        'c': nrm((BATCH, D), 1.0),
        'ctx': nrm((BATCH, CTX_LEN, D), 1.0),
        'c_ctx': nrm((D,), 1.0),
        'ada_w': nrm((L, D, N_MOD * D), 0.5 * D ** -0.5),
        'ada_b': nrm((L, N_MOD * D), 0.02),
        'mix_pre_g': gain((L, D)),
        'mix_post_g': gain((L, D)),
        'ffn_pre_g': gain((L, D)),
        'ffn_post_g': gain((L, D)),
        'w_in': nrm((L, D, IN_COLS), D ** -0.5),
        'q_norm_g': gain((L, Q_RANK)),
        'kv_norm_g': gain((L, KV_RANK)),
        'w_uq': nrm((L, Q_RANK, MLA_HEADS * (MLA_NOPE + MLA_ROPE)), Q_RANK ** -0.5),
        'w_ukv': nrm((L, KV_RANK, MLA_HEADS * (MLA_NOPE + MLA_V)), KV_RANK ** -0.5),
        'shift_mu': jax.random.uniform(next(ks), (L, 2, RWKV_COLS), jnp.float32, 0.0, 0.5),
        'decay_w0': nrm((L, N_DIR, RWKV_WIDTH), 0.5),
        'decay_w2': nrm((L, N_DIR, DECAY_LORA, RWKV_WIDTH), 0.5 * DECAY_LORA ** -0.5),
        'iclr_a0': nrm((L, N_DIR, RWKV_WIDTH), 0.5),
        'iclr_a2': nrm((L, N_DIR, ICLR_LORA, RWKV_WIDTH), 0.5 * ICLR_LORA ** -0.5),
        'gate_g2': nrm((L, GATE_LORA, RWKV_WIDTH), GATE_LORA ** -0.5),
        'k_k': 0.85 + nrm((L, RWKV_WIDTH), 0.05),
        'k_a': 1.0 + nrm((L, RWKV_WIDTH), 0.05),
        'r_k': nrm((L, RWKV_HEADS, RWKV_HEAD), 0.1),
        'lnx_g': gain((L, RWKV_WIDTH)),
        'lnx_b': nrm((L, RWKV_WIDTH), 0.02),
        'w_out': nrm((L, MIX_WIDTH, D), MIX_WIDTH ** -0.5),
        'router_w': nrm((D, N_EXPERTS), D ** -0.5),
        'router_bias': nrm((N_EXPERTS,), 0.01),
        'exp_w_gate': nrm((L, N_EXPERTS, D, EXPERT_HIDDEN), D ** -0.5),
        'exp_w_up': nrm((L, N_EXPERTS, D, EXPERT_HIDDEN), D ** -0.5),
        'exp_w_down': nrm((L, N_EXPERTS, EXPERT_HIDDEN, D), EXPERT_HIDDEN ** -0.5),
        'sh_w_gate': nrm((L, D, SHARED_HIDDEN), D ** -0.5),
        'sh_w_up': nrm((L, D, SHARED_HIDDEN), D ** -0.5),
        'sh_w_down': nrm((L, SHARED_HIDDEN, D), SHARED_HIDDEN ** -0.5),
    }


def reference(x, c, ctx, c_ctx, ada_w, ada_b, mix_pre_g, mix_post_g, ffn_pre_g, ffn_post_g,
              w_in, q_norm_g, kv_norm_g, w_uq, w_ukv, shift_mu, decay_w0, decay_w2, iclr_a0, iclr_a2,
              gate_g2, k_k, k_a, r_k, lnx_g, lnx_b, w_out, router_w, router_bias,
              exp_w_gate, exp_w_up, exp_w_down, sh_w_gate, sh_w_up, sh_w_down):
    rows = x.shape[1] // GRID_W
    rope = axial_rope_tables(rows)
    xc = ctx
    cond = jax.nn.silu(c)
    cond_ctx = jax.nn.silu(c_ctx)[None]
    for l in range(DEPTH):
        ctx_out = l < DEPTH - 1
        mod = jnp.split(cond @ ada_w[l] + ada_b[l], N_MOD, axis=-1)
        mod_c = jnp.split(cond_ctx @ ada_w[l] + ada_b[l], N_MOD, axis=-1)
        h = modulate(rmsnorm(x, mix_pre_g[l]), mod[0], mod[1])
        hc = modulate(rmsnorm(xc, mix_pre_g[l]), mod_c[0], mod_c[1])
        y, yc = parallel_mixer(h, hc, rope, w_in[l], q_norm_g[l], kv_norm_g[l], w_uq[l], w_ukv[l],
                               shift_mu[l], decay_w0[l], decay_w2[l], iclr_a0[l], iclr_a2[l], gate_g2[l],
                               k_k[l], k_a[l], r_k[l], lnx_g[l], lnx_b[l], w_out[l], ctx_out)
        x = x + mod[2][:, None] * rmsnorm(y, mix_post_g[l])
        h = modulate(rmsnorm(x, ffn_pre_g[l]), mod[3], mod[4])
        f = grouped_moe(h, router_w, router_bias, exp_w_gate[l], exp_w_up[l], exp_w_down[l],
                        sh_w_gate[l], sh_w_up[l], sh_w_down[l])
        x = x + mod[5][:, None] * rmsnorm(f, ffn_post_g[l])
        if ctx_out:
            xc = xc + mod_c[2][:, None] * rmsnorm(yc, mix_post_g[l])
            hc = modulate(rmsnorm(xc, ffn_pre_g[l]), mod_c[3], mod_c[4])
            fc = grouped_moe(hc, router_w, router_bias, exp_w_gate[l], exp_w_up[l], exp_w_down[l],
                             sh_w_gate[l], sh_w_up[l], sh_w_down[l])
            xc = xc + mod_c[5][:, None] * rmsnorm(fc, ffn_post_g[l])
    return x
```

```cpp
#include <hip/hip_runtime.h>
#include <stdint.h>

#define DI __device__ __forceinline__
typedef unsigned short bf16_t;

constexpr int D = 1024, NB = 4, SEQ = 4096, CTX = 256, DEPTH = 2;
constexpr int NLAT = NB * SEQ;
constexpr int NCTX = NB * CTX;
constexpr int NT = NLAT + NCTX;
constexpr int KEYS = SEQ + CTX;
constexpr int HEADS = 8;
constexpr int IN_COLS = 2368, MLA_COLS = 416, RW_COLS = 1952;
constexpr int NEXP = 16;
constexpr float EPS = 1e-6f;
constexpr float QSCALE = 0.10206207261596577f;

constexpr size_t WS_CTL  = 0;
constexpr size_t WS_MOD  = 65536;
constexpr size_t WS_XC   = WS_MOD + 2 * 5 * 6144 * 4;
constexpr size_t WS_TOPK = WS_XC + (size_t)NCTX * D * 4;
constexpr size_t WS_INV  = WS_TOPK + (size_t)NT * 16;
constexpr size_t WS_BUFA = WS_INV + (size_t)NEXP * NT * 4;
constexpr size_t WS_P    = WS_BUFA + (size_t)NT * 1024 * 2;
constexpr size_t WS_Q    = WS_P + (size_t)NT * IN_COLS * 2;
constexpr size_t WS_KN   = WS_Q + (size_t)NT * 768 * 2;
constexpr size_t WS_VT   = WS_KN + (size_t)NT * 512 * 2;
constexpr size_t WS_DEC  = WS_VT + (size_t)NT * 512 * 2;
constexpr size_t WS_AA   = WS_DEC + (size_t)NT * 1024 * 2;
constexpr size_t WS_KR   = WS_AA + (size_t)NT * 1024 * 2;
constexpr size_t WS_END  = WS_KR + (size_t)NT * 32 * 2;
static_assert(WS_END <= (size_t)256 * 1024 * 1024, "workspace over 256 MiB");
constexpr size_t WS_Y    = WS_P;
constexpr size_t WS_ACTS = WS_P + (size_t)NT * 1024 * 2;
constexpr size_t WS_ACTR = WS_ACTS + (size_t)NT * 256 * 2;
constexpr size_t WS_FS   = WS_Q;
constexpr size_t WS_R    = WS_DEC;
constexpr size_t WS_RW   = WS_DEC;
static_assert(WS_ACTR + (size_t)2 * NT * 256 * 2 <= WS_Q, "act overflow");
static_assert(WS_FS + (size_t)NT * 1024 * 2 <= WS_DEC, "fs overflow");

struct Params {
  const float* in[35];
  float* out;
  unsigned char* ws;
};

enum { I_X = 0, I_C, I_CTX, I_CCTX, I_ADAW, I_ADAB, I_MIXPRE, I_MIXPOST, I_FFNPRE, I_FFNPOST, I_WIN, I_QNG, I_KVNG, I_WUQ, I_WUKV,
       I_MU, I_W0, I_W2, I_A0, I_A2, I_G2, I_KK, I_KA, I_RK, I_LNG, I_LNB, I_WOUT, I_RW, I_RB, I_EG, I_EU, I_ED, I_SG, I_SU, I_SD };

DI float bf2f(bf16_t h) { return __uint_as_float(((unsigned)h) << 16); }
DI bf16_t f2bf(float x) { unsigned u = __float_as_uint(x); u += 0x7fffu + ((u >> 16) & 1u); return (bf16_t)(u >> 16); }
DI float sigm(float x) { return 1.f / (1.f + expf(-x)); }
DI float siluf(float x) { return x / (1.f + expf(-x)); }
DI float wave_sum(float v) {
#pragma unroll
  for (int o = 32; o > 0; o >>= 1) v += __shfl_xor(v, o);
  return v;
}
DI float sum16(float v) {
#pragma unroll
  for (int o = 8; o > 0; o >>= 1) v += __shfl_xor(v, o);
  return v;
}

struct RowInfo { int b, t, len, ctx; };
DI RowInfo rinfo(int r) {
  RowInfo q;
  if (r < NLAT) { q.b = r >> 12; q.t = r & 4095; q.len = SEQ; q.ctx = 0; }
  else { int u = r - NLAT; q.b = u >> 8; q.t = u & 255; q.len = CTX; q.ctx = 1; }
  return q;
}
DI int keyidx(const RowInfo& q) { return q.ctx ? SEQ + q.t : q.t; }
DI int modrow(const RowInfo& q) { return q.ctx ? 4 : q.b; }

DI float ps_val(const bf16_t* P, const float* mu, int r, const RowInfo& q, int c) {
  size_t o = (size_t)r * IN_COLS + MLA_COLS + c;
  float pc = bf2f(P[o]);
  float pv = q.t > 0 ? bf2f(P[o - IN_COLS]) : 0.f;
  float nx = q.t < q.len - 1 ? bf2f(P[o + IN_COLS]) : 0.f;
  return pc + mu[c] * (pv - pc) + mu[RW_COLS + c] * (nx - pc);
}

__global__ void __launch_bounds__(256) k_mod(Params p) {
  int i = blockIdx.x * 256 + threadIdx.x;
  if (i >= DEPTH * 6144) return;
  int l = i / 6144, n = i % 6144;
  const float* c = p.in[I_C]; const float* cc = p.in[I_CCTX];
  const float* W = p.in[I_ADAW] + (size_t)l * 1024 * 6144;
  float bias = p.in[I_ADAB][l * 6144 + n];
  float acc[5];
#pragma unroll
  for (int r = 0; r < 5; ++r) acc[r] = bias;
  for (int k = 0; k < 1024; ++k) {
    float w = W[(size_t)k * 6144 + n];
#pragma unroll
    for (int r = 0; r < 4; ++r) acc[r] += siluf(c[r * 1024 + k]) * w;
    acc[4] += siluf(cc[k]) * w;
  }
  float* MOD = (float*)(p.ws + WS_MOD);
#pragma unroll
  for (int r = 0; r < 5; ++r) MOD[(size_t)(l * 5 + r) * 6144 + n] = acc[r];
}

__global__ void __launch_bounds__(256) k_prenorm(Params p, int l) {
  int r = (blockIdx.x * 256 + threadIdx.x) >> 6, lane = threadIdx.x & 63;
  if (r >= NT) return;
  RowInfo q = rinfo(r);
  const float* xrow = q.ctx ? ((l == 0 ? p.in[I_CTX] : (const float*)(p.ws + WS_XC)) + (size_t)(r - NLAT) * D)
                            : ((l == 0 ? p.in[I_X] : (const float*)p.out) + (size_t)r * D);
  float v[16]; float ss = 0.f;
#pragma unroll
  for (int i = 0; i < 16; ++i) { v[i] = xrow[lane + 64 * i]; ss += v[i] * v[i]; }
  ss = wave_sum(ss);
  float rstd = rsqrtf(ss * (1.f / 1024.f) + EPS);
  const float* g = p.in[I_MIXPRE] + l * D;
  const float* mod = (const float*)(p.ws + WS_MOD) + (size_t)(l * 5 + modrow(q)) * 6144;
  bf16_t* H = (bf16_t*)(p.ws + WS_BUFA) + (size_t)r * D;
#pragma unroll
  for (int i = 0; i < 16; ++i) { int k = lane + 64 * i; H[k] = f2bf(v[i] * rstd * g[k] * (1.f + mod[1024 + k]) + mod[k]); }
}

__global__ void __launch_bounds__(256) k_gemm_naive(const bf16_t* A, int lda, const float* W, int ldw, bf16_t* C, int ldc, int M, int N, int K) {
  long idx = (long)blockIdx.x * 256 + threadIdx.x;
  if (idx >= (long)M * N) return;
  int r = (int)(idx / N), n = (int)(idx % N);
  const bf16_t* a = A + (size_t)r * lda;
  float acc = 0.f;
  for (int k = 0; k < K; ++k) acc += bf2f(a[k]) * W[(size_t)k * ldw + n];
  C[(size_t)r * ldc + n] = f2bf(acc);
}

DI void rope_pair(float a1, float a2, int i, const RowInfo& q, float& o1, float& o2) {
  if (q.ctx) { o1 = a1; o2 = a2; return; }
  float pos = (float)((i < 8) ? (q.t >> 6) : (q.t & 63));
  float fr = powf(10000.f, -(float)(i & 7) * 0.125f);
  float ang = pos * fr, c = cosf(ang), s = sinf(ang);
  o1 = a1 * c - a2 * s; o2 = a1 * s + a2 * c;
}
__global__ void __launch_bounds__(256) k_mla_naive(Params p, int l) {
  long idx = (long)blockIdx.x * 256 + threadIdx.x;
  if (idx >= (long)NT * 1680) return;
  int r = (int)(idx / 1680), j = (int)(idx % 1680);
  RowInfo q = rinfo(r);
  const bf16_t* prow = (const bf16_t*)(p.ws + WS_P) + (size_t)r * IN_COLS;
  bf16_t* Q = (bf16_t*)(p.ws + WS_Q) + (size_t)r * 768;
  int kr = q.b * KEYS + keyidx(q);
  if (j < 640) {
    int hh = j / 80, jj = j % 80;
    float ss = 0.f;
    for (int k = 0; k < 256; ++k) { float v = bf2f(prow[k]); ss += v * v; }
    float rs = rsqrtf(ss * (1.f / 256.f) + EPS);
    const float* gq = p.in[I_QNG] + l * 256; const float* W = p.in[I_WUQ] + (size_t)l * 256 * 768;
    if (jj < 64) {
      int n = hh * 96 + jj; float acc = 0.f;
      for (int k = 0; k < 256; ++k) acc += bf2f(prow[k]) * rs * gq[k] * W[k * 768 + n];
      Q[n] = f2bf(acc * QSCALE);
    } else {
      int i = jj - 64, n1 = hh * 96 + 64 + i, n2 = n1 + 16; float a1 = 0.f, a2 = 0.f;
      for (int k = 0; k < 256; ++k) { float v = bf2f(prow[k]) * rs * gq[k]; a1 += v * W[k * 768 + n1]; a2 += v * W[k * 768 + n2]; }
      float o1, o2; rope_pair(a1, a2, i, q, o1, o2);
      Q[n1] = f2bf(o1 * QSCALE); Q[n2] = f2bf(o2 * QSCALE);
    }
  } else if (j < 1664) {
    int n = j - 640, hh = n >> 7, jj = n & 127;
    float ss = 0.f;
    for (int k = 0; k < 128; ++k) { float v = bf2f(prow[256 + k]); ss += v * v; }
    float rs = rsqrtf(ss * (1.f / 128.f) + EPS);
    const float* gk = p.in[I_KVNG] + l * 128; const float* W = p.in[I_WUKV] + (size_t)l * 128 * 1024;
    float acc = 0.f;
    for (int k = 0; k < 128; ++k) acc += bf2f(prow[256 + k]) * rs * gk[k] * W[k * 1024 + n];
    if (jj < 64) ((bf16_t*)(p.ws + WS_KN))[((size_t)kr * 8 + hh) * 64 + jj] = f2bf(acc);
    else ((bf16_t*)(p.ws + WS_VT))[((size_t)(q.b * 8 + hh) * 64 + (jj - 64)) * KEYS + keyidx(q)] = f2bf(acc);
  } else {
    int i = j - 1664;
    float a1 = bf2f(prow[384 + i]), a2 = bf2f(prow[384 + 16 + i]), o1, o2;
    rope_pair(a1, a2, i, q, o1, o2);
    bf16_t* KR = (bf16_t*)(p.ws + WS_KR) + (size_t)kr * 32;
    KR[i] = f2bf(o1); KR[16 + i] = f2bf(o2);
  }
}

__global__ void __launch_bounds__(256) k_lora_naive(Params p, int l) {
  long idx = (long)blockIdx.x * 256 + threadIdx.x;
  if (idx >= (long)NT * 2048) return;
  int r = (int)(idx >> 11), j = (int)(idx & 2047);
  int kind = j >> 9, c = j & 511;
  RowInfo q = rinfo(r);
  const bf16_t* P = (const bf16_t*)(p.ws + WS_P);
  const float* mu = p.in[I_MU] + (size_t)l * 2 * RW_COLS;
  if (kind < 2) {
    int d = kind;
    float z = p.in[I_W0][(l * 2 + d) * 512 + c];
    const float* w2 = p.in[I_W2] + (size_t)(l * 2 + d) * 64 * 512;
    for (int jj = 0; jj < 64; ++jj) z += tanhf(ps_val(P, mu, r, q, 1536 + d * 64 + jj)) * w2[jj * 512 + c];
    ((bf16_t*)(p.ws + WS_DEC))[((size_t)r * 2 + d) * 512 + c] = f2bf(0.6065306597126334f * sigm(z));
  } else {
    int d = kind - 2;
    float z = p.in[I_A0][(l * 2 + d) * 512 + c];
    const float* a2 = p.in[I_A2] + (size_t)(l * 2 + d) * 64 * 512;
    for (int jj = 0; jj < 64; ++jj) z += ps_val(P, mu, r, q, 1664 + d * 64 + jj) * a2[jj * 512 + c];
    ((bf16_t*)(p.ws + WS_AA))[((size_t)r * 2 + d) * 512 + c] = f2bf(sigm(z));
  }
}

__global__ void __launch_bounds__(256) k_attn_naive(Params p) {
  int rb = blockIdx.x >> 3, h = blockIdx.x & 7;
  int r = rb * 256 + threadIdx.x;
  RowInfo q = rinfo(r);
  int b = __builtin_amdgcn_readfirstlane(q.b), isctx = __builtin_amdgcn_readfirstlane(q.ctx);
  bf16_t* Q = (bf16_t*)(p.ws + WS_Q) + (size_t)r * 768 + h * 96;
  float qv[96];
#pragma unroll
  for (int d = 0; d < 96; ++d) qv[d] = bf2f(Q[d]);
  float o[64];
#pragma unroll
  for (int d = 0; d < 64; ++d) o[d] = 0.f;
  float m = -1e30f, ls = 0.f;
  const bf16_t* KN = (const bf16_t*)(p.ws + WS_KN);
  const bf16_t* KR = (const bf16_t*)(p.ws + WS_KR);
  const bf16_t* VT = (const bf16_t*)(p.ws + WS_VT) + (size_t)(b * 8 + h) * 64 * KEYS;
  for (int kidx = isctx ? SEQ : 0; kidx < KEYS; ++kidx) {
    int kr = b * KEYS + kidx;
    const bf16_t* kn = KN + ((size_t)kr * 8 + h) * 64;
    const bf16_t* krp = KR + (size_t)kr * 32;
    float s = 0.f;
#pragma unroll
    for (int d = 0; d < 64; ++d) s += qv[d] * bf2f(kn[d]);
#pragma unroll
    for (int d = 0; d < 32; ++d) s += qv[64 + d] * bf2f(krp[d]);
    if (s > m) {
      float al = expf(m - s); ls *= al;
#pragma unroll
      for (int d = 0; d < 64; ++d) o[d] *= al;
      m = s;
    }
    float pp = expf(s - m); ls += pp;
#pragma unroll
    for (int d = 0; d < 64; ++d) o[d] += pp * bf2f(VT[(size_t)d * KEYS + kidx]);
  }
  float inv = 1.f / ls;
#pragma unroll
  for (int d = 0; d < 64; ++d) Q[d] = f2bf(o[d] * inv);
}

__global__ void __launch_bounds__(256) k_scan_naive(Params p, int l) {
  int job = blockIdx.x >> 2, quarter = blockIdx.x & 3;
  int d = job & 1, h = (job >> 1) & 7, b = job >> 4;
  int w = threadIdx.x >> 6, lane = threadIdx.x & 63;
  int i = quarter * 16 + w * 4 + (lane >> 4), part = lane & 15;
  const bf16_t* P = (const bf16_t*)(p.ws + WS_P);
  const bf16_t* DEC = (const bf16_t*)(p.ws + WS_DEC);
  const bf16_t* AA = (const bf16_t*)(p.ws + WS_AA);
  bf16_t* YS = (bf16_t*)(p.ws + WS_BUFA) + (size_t)d * NT * 512;
  const float* mu = p.in[I_MU] + (size_t)l * 2 * RW_COLS;
  float kkw[4], kaw[4];
#pragma unroll
  for (int j = 0; j < 4; ++j) { kkw[j] = p.in[I_KK][l * 512 + h * 64 + part * 4 + j]; kaw[j] = p.in[I_KA][l * 512 + h * 64 + part * 4 + j]; }
  float S[4] = {0.f, 0.f, 0.f, 0.f};
  for (int step = 0; step < CTX + SEQ; ++step) {
    int r;
    if (step < CTX) { int t = d ? (CTX - 1 - step) : step; r = NLAT + b * CTX + t; }
    else { int s2 = step - CTX; int t = d ? (SEQ - 1 - s2) : s2; r = b * SEQ + t; }
    RowInfo q = rinfo(r);
    float rr[4], kraw[4], kk[4], aa[4], wd[4];
    float ss = 0.f;
#pragma unroll
    for (int j = 0; j < 4; ++j) {
      int c = h * 64 + part * 4 + j;
      rr[j] = ps_val(P, mu, r, q, c);
      kraw[j] = ps_val(P, mu, r, q, 512 + c);
      aa[j] = bf2f(AA[((size_t)r * 2 + d) * 512 + c]);
      wd[j] = expf(-bf2f(DEC[((size_t)r * 2 + d) * 512 + c]));
      kk[j] = kraw[j] * kkw[j]; ss += kk[j] * kk[j];
    }
    float vv = ps_val(P, mu, r, q, 1024 + h * 64 + i);
    ss = sum16(ss);
    float rn = rsqrtf(ss + 1e-12f);
    float sk = 0.f;
#pragma unroll
    for (int j = 0; j < 4; ++j) { kk[j] *= rn; sk += S[j] * kk[j]; }
    sk = sum16(sk);
    float y = 0.f;
#pragma unroll
    for (int j = 0; j < 4; ++j) {
      float keff = kraw[j] * (1.f + (aa[j] - 1.f) * kaw[j]);
      S[j] = S[j] * wd[j] - sk * (kk[j] * aa[j]) + vv * keff;
      y += S[j] * rr[j];
    }
    y = sum16(y);
    if (part == 0) YS[(size_t)r * 512 + h * 64 + i] = f2bf(y);
  }
}

__global__ void __launch_bounds__(256) k_rwkvout_naive(Params p, int l) {
  int wv = (blockIdx.x * 256 + threadIdx.x) >> 6, lane = threadIdx.x & 63;
  if (wv >= NT * 8) return;
  int r = wv >> 3, h = wv & 7, c = h * 64 + lane;
  RowInfo q = rinfo(r);
  const bf16_t* P = (const bf16_t*)(p.ws + WS_P);
  const bf16_t* AA = (const bf16_t*)(p.ws + WS_AA);
  const bf16_t* YS = (const bf16_t*)(p.ws + WS_BUFA);
  const float* mu = p.in[I_MU] + (size_t)l * 2 * RW_COLS;
  float y = bf2f(YS[(size_t)r * 512 + c]) + bf2f(YS[(size_t)NT * 512 + (size_t)r * 512 + c]);
  float mean = wave_sum(y) * (1.f / 64.f);
  float dv = y - mean;
  float var = wave_sum(dv * dv) * (1.f / 64.f);
  float yn = dv * rsqrtf(var + 64e-5f) * p.in[I_LNG][l * 512 + c] + p.in[I_LNB][l * 512 + c];
  float rr = ps_val(P, mu, r, q, c), kraw = ps_val(P, mu, r, q, 512 + c), vv = ps_val(P, mu, r, q, 1024 + c);
  float ka = p.in[I_KA][l * 512 + c];
  float a0 = bf2f(AA[((size_t)r * 2 + 0) * 512 + c]), a1 = bf2f(AA[((size_t)r * 2 + 1) * 512 + c]);
  float keffsum = kraw * (1.f + (a0 - 1.f) * ka) + kraw * (1.f + (a1 - 1.f) * ka);
  float bonus = wave_sum(rr * keffsum * p.in[I_RK][l * 512 + c]);
  const float* g2 = p.in[I_G2] + (size_t)l * 160 * 512;
  float g = 0.f;
  for (int j = 0; j < 160; ++j) g += sigm(ps_val(P, mu, r, q, 1792 + j)) * g2[j * 512 + c];
  ((bf16_t*)(p.ws + WS_RW))[(size_t)r * 512 + c] = f2bf((yn + bonus * vv) * g);
}

__global__ void __launch_bounds__(256) k_wout_naive(Params p, int l) {
  long idx = (long)blockIdx.x * 256 + threadIdx.x;
  if (idx >= (long)NT * 1024) return;
  int r = (int)(idx >> 10), n = (int)(idx & 1023);
  const bf16_t* Q = (const bf16_t*)(p.ws + WS_Q) + (size_t)r * 768;
  const bf16_t* RW = (const bf16_t*)(p.ws + WS_RW) + (size_t)r * 512;
  const float* W = p.in[I_WOUT] + (size_t)l * 1024 * 1024;
  float acc = 0.f;
  for (int k = 0; k < 512; ++k) acc += bf2f(Q[(k >> 6) * 96 + (k & 63)]) * W[(size_t)k * 1024 + n];
  for (int k = 0; k < 512; ++k) acc += bf2f(RW[k]) * W[(size_t)(512 + k) * 1024 + n];
  ((bf16_t*)(p.ws + WS_Y))[(size_t)r * 1024 + n] = f2bf(acc);
}

__global__ void __launch_bounds__(256) k_postmix(Params p, int l) {
  int r = (blockIdx.x * 256 + threadIdx.x) >> 6, lane = threadIdx.x & 63;
  if (r >= NT) return;
  RowInfo q = rinfo(r);
  const float* xin = q.ctx ? ((l == 0 ? p.in[I_CTX] : (const float*)(p.ws + WS_XC)) + (size_t)(r - NLAT) * D)
                           : ((l == 0 ? p.in[I_X] : (const float*)p.out) + (size_t)r * D);
  float* xout = q.ctx ? ((float*)(p.ws + WS_XC) + (size_t)(r - NLAT) * D) : (p.out + (size_t)r * D);
  const bf16_t* Y = (const bf16_t*)(p.ws + WS_Y) + (size_t)r * D;
  const float* mod = (const float*)(p.ws + WS_MOD) + (size_t)(l * 5 + modrow(q)) * 6144;
  float yv[16], xv[16]; float ss = 0.f;
#pragma unroll
  for (int i = 0; i < 16; ++i) { yv[i] = bf2f(Y[lane + 64 * i]); ss += yv[i] * yv[i]; }
  ss = wave_sum(ss);
  float rstd = rsqrtf(ss * (1.f / 1024.f) + EPS);
  const float* gpost = p.in[I_MIXPOST] + l * D;
  float s2 = 0.f;
#pragma unroll
  for (int i = 0; i < 16; ++i) { int k = lane + 64 * i; xv[i] = xin[k] + mod[2 * 1024 + k] * (yv[i] * rstd * gpost[k]); s2 += xv[i] * xv[i]; xout[k] = xv[i]; }
  s2 = wave_sum(s2);
  float rstd2 = rsqrtf(s2 * (1.f / 1024.f) + EPS);
  const float* gpre = p.in[I_FFNPRE] + l * D;
  bf16_t* H2 = (bf16_t*)(p.ws + WS_BUFA) + (size_t)r * D;
  const float* RWt = p.in[I_RW];
  float lg[16];
#pragma unroll
  for (int e = 0; e < 16; ++e) lg[e] = 0.f;
#pragma unroll
  for (int i = 0; i < 16; ++i) {
    int k = lane + 64 * i;
    float hv = xv[i] * rstd2 * gpre[k] * (1.f + mod[4 * 1024 + k]) + mod[3 * 1024 + k];
    H2[k] = f2bf(hv);
#pragma unroll
    for (int e = 0; e < 16; ++e) lg[e] += hv * RWt[k * 16 + e];
  }
#pragma unroll
  for (int e = 0; e < 16; ++e) lg[e] = wave_sum(lg[e]);
  if (lane == 0) {
    float sc[16], bi[16];
#pragma unroll
    for (int e = 0; e < 16; ++e) { sc[e] = sigm(lg[e]); bi[e] = sc[e] + p.in[I_RB][e]; }
    float bgs = -1e30f; int e1 = 0, e2 = 0; float w1 = 0.f, w2 = 0.f;
#pragma unroll
    for (int g = 0; g < 4; ++g) {
      float m1 = -1e30f, m2 = -1e30f, s1v = 0.f, s2v = 0.f; int i1 = 0, i2 = 0;
#pragma unroll
      for (int j = 0; j < 4; ++j) {
        float v = bi[g * 4 + j], s = sc[g * 4 + j];
        if (v > m1) { m2 = m1; i2 = i1; s2v = s1v; m1 = v; i1 = j; s1v = s; }
        else if (v > m2) { m2 = v; i2 = j; s2v = s; }
      }
      float gs = m1 + m2;
      if (gs > bgs) { bgs = gs; e1 = g * 4 + i1; e2 = g * 4 + i2; w1 = s1v; w2 = s2v; }
    }
    float inv = 1.f / (w1 + w2);
    int* CNT = (int*)(p.ws + WS_CTL) + l * 16;
    int* INV = (int*)(p.ws + WS_INV);
    int s1 = atomicAdd(&CNT[e1], 1), sl2 = atomicAdd(&CNT[e2], 1);
    INV[(size_t)e1 * NT + s1] = r; INV[(size_t)e2 * NT + sl2] = r;
    int* POS = (int*)(p.ws + WS_TOPK); float* GW = (float*)(p.ws + WS_TOPK + (size_t)NT * 8);
    POS[r * 2] = (e1 << 20) | s1; POS[r * 2 + 1] = (e2 << 20) | sl2;
    GW[r * 2] = w1 * inv; GW[r * 2 + 1] = w2 * inv;
  }
}

DI int expert_off(const int* CNT, int e) { int a = 0; for (int t = 0; t < 16; ++t) a += (t < e) ? CNT[t] : 0; return a; }
DI void expert_of_row(const int* CNT, int sr, int& e, int& base) { int a = 0; e = 0; base = 0; for (int t = 0; t < 16; ++t) { if (sr >= a) { e = t; base = a; } a += CNT[t]; } }

__global__ void __launch_bounds__(256) k_moe_up_naive(Params p, int l) {
  long idx = (long)blockIdx.x * 256 + threadIdx.x;
  if (idx >= (long)3 * NT * 256) return;
  int row = (int)(idx >> 8), j = (int)(idx & 255);
  const bf16_t* H2 = (const bf16_t*)(p.ws + WS_BUFA);
  if (row < NT) {
    const bf16_t* h = H2 + (size_t)row * D;
    const float* wg = p.in[I_SG] + (size_t)l * 1024 * 256; const float* wu = p.in[I_SU] + (size_t)l * 1024 * 256;
    float g = 0.f, u = 0.f;
    for (int k = 0; k < 1024; ++k) { float hv = bf2f(h[k]); g += hv * wg[k * 256 + j]; u += hv * wu[k * 256 + j]; }
    ((bf16_t*)(p.ws + WS_ACTS))[(size_t)row * 256 + j] = f2bf(siluf(g) * u);
  } else {
    int sr = row - NT;
    const int* CNT = (const int*)(p.ws + WS_CTL) + l * 16;
    int e, base; expert_of_row(CNT, sr, e, base);
    int r = ((const int*)(p.ws + WS_INV))[(size_t)e * NT + (sr - base)];
    const bf16_t* h = H2 + (size_t)r * D;
    const float* wg = p.in[I_EG] + (size_t)(l * 16 + e) * 1024 * 256; const float* wu = p.in[I_EU] + (size_t)(l * 16 + e) * 1024 * 256;
    float g = 0.f, u = 0.f;
    for (int k = 0; k < 1024; ++k) { float hv = bf2f(h[k]); g += hv * wg[k * 256 + j]; u += hv * wu[k * 256 + j]; }
    ((bf16_t*)(p.ws + WS_ACTR))[(size_t)sr * 256 + j] = f2bf(siluf(g) * u);
  }
}

__global__ void __launch_bounds__(256) k_moe_down_naive(Params p, int l) {
  long idx = (long)blockIdx.x * 256 + threadIdx.x;
  if (idx >= (long)3 * NT * 1024) return;
  int row = (int)(idx >> 10), n = (int)(idx & 1023);
  if (row < NT) {
    const bf16_t* a = (const bf16_t*)(p.ws + WS_ACTS) + (size_t)row * 256;
    const float* wd = p.in[I_SD] + (size_t)l * 256 * 1024;
    float acc = 0.f;
    for (int k = 0; k < 256; ++k) acc += bf2f(a[k]) * wd[k * 1024 + n];
    ((bf16_t*)(p.ws + WS_FS))[(size_t)row * 1024 + n] = f2bf(acc);
  } else {
    int sr = row - NT;
    const int* CNT = (const int*)(p.ws + WS_CTL) + l * 16;
    int e, base; expert_of_row(CNT, sr, e, base);
    const bf16_t* a = (const bf16_t*)(p.ws + WS_ACTR) + (size_t)sr * 256;
    const float* wd = p.in[I_ED] + (size_t)(l * 16 + e) * 256 * 1024;
    float acc = 0.f;
    for (int k = 0; k < 256; ++k) acc += bf2f(a[k]) * wd[k * 1024 + n];
    ((bf16_t*)(p.ws + WS_R))[(size_t)sr * 1024 + n] = f2bf(acc);
  }
}

__global__ void __launch_bounds__(256) k_postffn(Params p, int l) {
  int r = (blockIdx.x * 256 + threadIdx.x) >> 6, lane = threadIdx.x & 63;
  if (r >= NT) return;
  RowInfo q = rinfo(r);
  float* x = q.ctx ? ((float*)(p.ws + WS_XC) + (size_t)(r - NLAT) * D) : (p.out + (size_t)r * D);
  const int* CNT = (const int*)(p.ws + WS_CTL) + l * 16;
  const int* POS = (const int*)(p.ws + WS_TOPK); const float* GW = (const float*)(p.ws + WS_TOPK + (size_t)NT * 8);
  int p1 = POS[r * 2], p2 = POS[r * 2 + 1];
  size_t r1 = (size_t)(expert_off(CNT, p1 >> 20) + (p1 & 0xFFFFF)), r2 = (size_t)(expert_off(CNT, p2 >> 20) + (p2 & 0xFFFFF));
  float w1 = GW[r * 2], w2 = GW[r * 2 + 1];
  const bf16_t* FS = (const bf16_t*)(p.ws + WS_FS) + (size_t)r * D;
  const bf16_t* R1 = (const bf16_t*)(p.ws + WS_R) + r1 * D;
  const bf16_t* R2 = (const bf16_t*)(p.ws + WS_R) + r2 * D;
  const float* mod = (const float*)(p.ws + WS_MOD) + (size_t)(l * 5 + modrow(q)) * 6144;
  const float* g = p.in[I_FFNPOST] + l * D;
  float f[16]; float ss = 0.f;
#pragma unroll
  for (int i = 0; i < 16; ++i) { int k = lane + 64 * i; f[i] = bf2f(FS[k]) + w1 * bf2f(R1[k]) + w2 * bf2f(R2[k]); ss += f[i] * f[i]; }
  ss = wave_sum(ss);
  float rstd = rsqrtf(ss * (1.f / 1024.f) + EPS);
#pragma unroll
  for (int i = 0; i < 16; ++i) { int k = lane + 64 * i; x[k] = x[k] + mod[5 * 1024 + k] * (f[i] * rstd * g[k]); }
}

static inline int cdiv(long a, long b) { return (int)((a + b - 1) / b); }

extern "C" void kernel_launch(void* const* d_in, const int* in_sizes, int n_in, void* d_out, int out_size, void* d_ws, size_t ws_size,
                              hipStream_t stream) {
  Params p{};
  for (int i = 0; i < 35; ++i) p.in[i] = (const float*)d_in[i];
  p.out = (float*)d_out; p.ws = (unsigned char*)d_ws;
  hipMemsetAsync((char*)d_ws + WS_CTL, 0, 65536, stream);
  bf16_t* wsb = (bf16_t*)0; (void)wsb;
  unsigned char* ws = (unsigned char*)d_ws;
  k_mod<<<cdiv(DEPTH * 6144, 256), 256, 0, stream>>>(p);
  for (int l = 0; l < DEPTH; ++l) {
    k_prenorm<<<cdiv((long)NT * 64, 256), 256, 0, stream>>>(p, l);
    k_gemm_naive<<<cdiv((long)NT * IN_COLS, 256), 256, 0, stream>>>((const bf16_t*)(ws + WS_BUFA), 1024, p.in[I_WIN] + (size_t)l * 1024 * IN_COLS, IN_COLS,
                                                                    (bf16_t*)(ws + WS_P), IN_COLS, NT, IN_COLS, 1024);
    k_mla_naive<<<cdiv((long)NT * 1680, 256), 256, 0, stream>>>(p, l);
    k_lora_naive<<<cdiv((long)NT * 2048, 256), 256, 0, stream>>>(p, l);
    k_attn_naive<<<(NT / 256) * 8, 256, 0, stream>>>(p);
    k_scan_naive<<<256, 256, 0, stream>>>(p, l);
    k_rwkvout_naive<<<cdiv((long)NT * 8 * 64, 256), 256, 0, stream>>>(p, l);
    k_wout_naive<<<cdiv((long)NT * 1024, 256), 256, 0, stream>>>(p, l);
    k_postmix<<<cdiv((long)NT * 64, 256), 256, 0, stream>>>(p, l);
    k_moe_up_naive<<<cdiv((long)3 * NT * 256, 256), 256, 0, stream>>>(p, l);
    k_moe_down_naive<<<cdiv((long)3 * NT * 1024, 256), 256, 0, stream>>>(p, l);
    k_postffn<<<cdiv((long)NT * 64, 256), 256, 0, stream>>>(p, l);
  }
}
```

```cpp
#include <hip/hip_runtime.h>
#include <hip/hip_cooperative_groups.h>
#include <stdint.h>
#include <stdio.h>
namespace cg = cooperative_groups;

#define DI __device__ __forceinline__
typedef unsigned short bf16_t;

constexpr int D = 1024, NB = 4, SEQ = 4096, CTX = 256, DEPTH = 2;
constexpr int NLAT = NB * SEQ;
constexpr int NCTX = NB * CTX;
constexpr int NT = NLAT + NCTX;
constexpr int KEYS = SEQ + CTX;
constexpr int HEADS = 8;
constexpr int IN_COLS = 2368, MLA_COLS = 416, RW_COLS = 1952;
constexpr int NEXP = 16;
constexpr int NTHR = 512;
constexpr float EPS = 1e-6f;
constexpr float QSCALE = 0.10206207261596577f;

constexpr size_t WS_CTL  = 0;
constexpr size_t WS_MOD  = 65536;
constexpr size_t WS_XC   = WS_MOD + 2 * 5 * 6144 * 4;
constexpr size_t WS_TOPK = WS_XC + (size_t)NCTX * D * 4;
constexpr size_t WS_INV  = WS_TOPK + (size_t)NT * 16;
constexpr size_t WS_BUFA = WS_INV + (size_t)NEXP * NT * 4;
constexpr size_t WS_P    = WS_BUFA + (size_t)NT * 1024 * 2;
constexpr size_t WS_Q    = WS_P + (size_t)NT * IN_COLS * 2;
constexpr size_t WS_KN   = WS_Q + (size_t)NT * 768 * 2;
constexpr size_t WS_VT   = WS_KN + (size_t)NT * 512 * 2;
constexpr size_t WS_DEC  = WS_VT + (size_t)NT * 512 * 2;
constexpr size_t WS_AA   = WS_DEC + (size_t)NT * 1024 * 2;
constexpr size_t WS_KR   = WS_AA + (size_t)NT * 1024 * 2;
constexpr size_t WS_END  = WS_KR + (size_t)NT * 32 * 2;
static_assert(WS_END <= (size_t)256 * 1024 * 1024, "workspace over 256 MiB");
constexpr size_t WS_Y    = WS_P;
constexpr size_t WS_ACTS = WS_P + (size_t)NT * 1024 * 2;
constexpr size_t WS_ACTR = WS_ACTS + (size_t)NT * 256 * 2;
constexpr size_t WS_FS   = WS_Q;
constexpr size_t WS_R    = WS_DEC;
constexpr size_t WS_RW   = WS_DEC;
static_assert(WS_ACTR + (size_t)2 * NT * 256 * 2 <= WS_Q, "act overflow");
static_assert(WS_FS + (size_t)NT * 1024 * 2 <= WS_DEC, "fs overflow");

struct Params {
  const float* in[35];
  float* out;
  unsigned char* ws;
};
__shared__ unsigned long long s_ptr[40];
struct PT {
  struct In { DI const float* operator[](int i) const {
      unsigned long long v = s_ptr[i];
      unsigned lo = __builtin_amdgcn_readfirstlane((unsigned)v), hi = __builtin_amdgcn_readfirstlane((unsigned)(v >> 32));
      return (const float*)(((unsigned long long)hi << 32) | lo); } } in;
  float* out;
  unsigned char* ws;
};

enum { I_X = 0, I_C, I_CTX, I_CCTX, I_ADAW, I_ADAB, I_MIXPRE, I_MIXPOST, I_FFNPRE, I_FFNPOST, I_WIN, I_QNG, I_KVNG, I_WUQ, I_WUKV,
       I_MU, I_W0, I_W2, I_A0, I_A2, I_G2, I_KK, I_KA, I_RK, I_LNG, I_LNB, I_WOUT, I_RW, I_RB, I_EG, I_EU, I_ED, I_SG, I_SU, I_SD };

DI float bf2f(bf16_t h) { return __uint_as_float(((unsigned)h) << 16); }
DI bf16_t f2bf(float x) { unsigned u = __float_as_uint(x); u += 0x7fffu + ((u >> 16) & 1u); return (bf16_t)(u >> 16); }
DI float sigm(float x) { return 1.f / (1.f + expf(-x)); }
DI float siluf(float x) { return x / (1.f + expf(-x)); }
DI float wave_sum(float v) {
#pragma unroll
  for (int o = 32; o > 0; o >>= 1) v += __shfl_xor(v, o);
  return v;
}
DI float sum16(float v) {
#pragma unroll
  for (int o = 8; o > 0; o >>= 1) v += __shfl_xor(v, o);
  return v;
}

struct RowInfo { int b, t, len, ctx; };
DI RowInfo rinfo(int r) {
  RowInfo q;
  if (r < NLAT) { q.b = r >> 12; q.t = r & 4095; q.len = SEQ; q.ctx = 0; }
  else { int u = r - NLAT; q.b = u >> 8; q.t = u & 255; q.len = CTX; q.ctx = 1; }
  return q;
}
DI int keyidx(const RowInfo& q) { return q.ctx ? SEQ + q.t : q.t; }
DI int modrow(const RowInfo& q) { return q.ctx ? 4 : q.b; }

DI float ps_val(const bf16_t* P, const float* mu, int r, const RowInfo& q, int c) {
  size_t o = (size_t)r * IN_COLS + MLA_COLS + c;
  float pc = bf2f(P[o]);
  float pv = q.t > 0 ? bf2f(P[o - IN_COLS]) : 0.f;
  float nx = q.t < q.len - 1 ? bf2f(P[o + IN_COLS]) : 0.f;
  return pc + mu[c] * (pv - pc) + mu[RW_COLS + c] * (nx - pc);
}

DI void ph_mod(const PT& p) {
  for (int i = blockIdx.x * NTHR + threadIdx.x; i < DEPTH * 6144; i += gridDim.x * NTHR) {
  int l = i / 6144, n = i % 6144;
  const float* c = p.in[I_C]; const float* cc = p.in[I_CCTX];
  const float* W = p.in[I_ADAW] + (size_t)l * 1024 * 6144;
  float bias = p.in[I_ADAB][l * 6144 + n];
  float acc[5];
#pragma unroll
  for (int r = 0; r < 5; ++r) acc[r] = bias;
  for (int k = 0; k < 1024; ++k) {
    float w = W[(size_t)k * 6144 + n];
#pragma unroll
    for (int r = 0; r < 4; ++r) acc[r] += siluf(c[r * 1024 + k]) * w;
    acc[4] += siluf(cc[k]) * w;
  }
  float* MOD = (float*)(p.ws + WS_MOD);
#pragma unroll
  for (int r = 0; r < 5; ++r) MOD[(size_t)(l * 5 + r) * 6144 + n] = acc[r];
  }
}

DI void ph_prenorm(const PT& p, int l) {
  const int lane = threadIdx.x & 63;
  for (int r = (blockIdx.x * NTHR + threadIdx.x) >> 6; r < NT; r += (gridDim.x * NTHR) >> 6) {
  RowInfo q = rinfo(r);
  const float* xrow = q.ctx ? ((l == 0 ? p.in[I_CTX] : (const float*)(p.ws + WS_XC)) + (size_t)(r - NLAT) * D)
                            : ((l == 0 ? p.in[I_X] : (const float*)p.out) + (size_t)r * D);
  float v[16]; float ss = 0.f;
#pragma unroll
  for (int i = 0; i < 16; ++i) { v[i] = xrow[lane + 64 * i]; ss += v[i] * v[i]; }
  ss = wave_sum(ss);
  float rstd = rsqrtf(ss * (1.f / 1024.f) + EPS);
  const float* g = p.in[I_MIXPRE] + l * D;
  const float* mod = (const float*)(p.ws + WS_MOD) + (size_t)(l * 5 + modrow(q)) * 6144;
  bf16_t* H = (bf16_t*)(p.ws + WS_BUFA) + (size_t)r * D;
#pragma unroll
  for (int i = 0; i < 16; ++i) { int k = lane + 64 * i; H[k] = f2bf(v[i] * rstd * g[k] * (1.f + mod[1024 + k]) + mod[k]); }
  }
}

DI void gemm_naive(const bf16_t* A, int lda, const float* W, int ldw, bf16_t* C, int ldc, int M, int N, int K) {
  for (long idx = (long)blockIdx.x * NTHR + threadIdx.x; idx < (long)M * N; idx += (long)gridDim.x * NTHR) {
  int r = (int)(idx / N), n = (int)(idx % N);
  const bf16_t* a = A + (size_t)r * lda;
  float acc = 0.f;
  for (int k = 0; k < K; ++k) acc += bf2f(a[k]) * W[(size_t)k * ldw + n];
  C[(size_t)r * ldc + n] = f2bf(acc);
  }
}

DI void rope_pair(float a1, float a2, int i, const RowInfo& q, float& o1, float& o2) {
  if (q.ctx) { o1 = a1; o2 = a2; return; }
  float pos = (float)((i < 8) ? (q.t >> 6) : (q.t & 63));
  float fr = powf(10000.f, -(float)(i & 7) * 0.125f);
  float ang = pos * fr, c = cosf(ang), s = sinf(ang);
  o1 = a1 * c - a2 * s; o2 = a1 * s + a2 * c;
}
DI void ph_mla(const PT& p, int l) {
  for (long idx = (long)blockIdx.x * NTHR + threadIdx.x; idx < (long)NT * 1680; idx += (long)gridDim.x * NTHR) {
  int r = (int)(idx / 1680), j = (int)(idx % 1680);
  RowInfo q = rinfo(r);
  const bf16_t* prow = (const bf16_t*)(p.ws + WS_P) + (size_t)r * IN_COLS;
  bf16_t* Q = (bf16_t*)(p.ws + WS_Q) + (size_t)r * 768;
  int kr = q.b * KEYS + keyidx(q);
  if (j < 640) {
    int hh = j / 80, jj = j % 80;
    float ss = 0.f;
    for (int k = 0; k < 256; ++k) { float v = bf2f(prow[k]); ss += v * v; }
    float rs = rsqrtf(ss * (1.f / 256.f) + EPS);
    const float* gq = p.in[I_QNG] + l * 256; const float* W = p.in[I_WUQ] + (size_t)l * 256 * 768;
    if (jj < 64) {
      int n = hh * 96 + jj; float acc = 0.f;
      for (int k = 0; k < 256; ++k) acc += bf2f(prow[k]) * rs * gq[k] * W[k * 768 + n];
      Q[n] = f2bf(acc * QSCALE);
    } else {
      int i = jj - 64, n1 = hh * 96 + 64 + i, n2 = n1 + 16; float a1 = 0.f, a2 = 0.f;
      for (int k = 0; k < 256; ++k) { float v = bf2f(prow[k]) * rs * gq[k]; a1 += v * W[k * 768 + n1]; a2 += v * W[k * 768 + n2]; }
      float o1, o2; rope_pair(a1, a2, i, q, o1, o2);
      Q[n1] = f2bf(o1 * QSCALE); Q[n2] = f2bf(o2 * QSCALE);
    }
  } else if (j < 1664) {
    int n = j - 640, hh = n >> 7, jj = n & 127;
    float ss = 0.f;
    for (int k = 0; k < 128; ++k) { float v = bf2f(prow[256 + k]); ss += v * v; }
    float rs = rsqrtf(ss * (1.f / 128.f) + EPS);
    const float* gk = p.in[I_KVNG] + l * 128; const float* W = p.in[I_WUKV] + (size_t)l * 128 * 1024;
    float acc = 0.f;
    for (int k = 0; k < 128; ++k) acc += bf2f(prow[256 + k]) * rs * gk[k] * W[k * 1024 + n];
    if (jj < 64) ((bf16_t*)(p.ws + WS_KN))[((size_t)kr * 8 + hh) * 64 + jj] = f2bf(acc);
    else ((bf16_t*)(p.ws + WS_VT))[((size_t)(q.b * 8 + hh) * 64 + (jj - 64)) * KEYS + keyidx(q)] = f2bf(acc);
  } else {
    int i = j - 1664;
    float a1 = bf2f(prow[384 + i]), a2 = bf2f(prow[384 + 16 + i]), o1, o2;
    rope_pair(a1, a2, i, q, o1, o2);
    bf16_t* KR = (bf16_t*)(p.ws + WS_KR) + (size_t)kr * 32;
    KR[i] = f2bf(o1); KR[16 + i] = f2bf(o2);
  }
  }
}

DI void ph_lora(const PT& p, int l) {
  for (long idx = (long)blockIdx.x * NTHR + threadIdx.x; idx < (long)NT * 2048; idx += (long)gridDim.x * NTHR) {
  int r = (int)(idx >> 11), j = (int)(idx & 2047);
  int kind = j >> 9, c = j & 511;
  RowInfo q = rinfo(r);
  const bf16_t* P = (const bf16_t*)(p.ws + WS_P);
  const float* mu = p.in[I_MU] + (size_t)l * 2 * RW_COLS;
  if (kind < 2) {
    int d = kind;
    float z = p.in[I_W0][(l * 2 + d) * 512 + c];
    const float* w2 = p.in[I_W2] + (size_t)(l * 2 + d) * 64 * 512;
    for (int jj = 0; jj < 64; ++jj) z += tanhf(ps_val(P, mu, r, q, 1536 + d * 64 + jj)) * w2[jj * 512 + c];
    ((bf16_t*)(p.ws + WS_DEC))[((size_t)r * 2 + d) * 512 + c] = f2bf(0.6065306597126334f * sigm(z));
  } else {
    int d = kind - 2;
    float z = p.in[I_A0][(l * 2 + d) * 512 + c];
    const float* a2 = p.in[I_A2] + (size_t)(l * 2 + d) * 64 * 512;
    for (int jj = 0; jj < 64; ++jj) z += ps_val(P, mu, r, q, 1664 + d * 64 + jj) * a2[jj * 512 + c];
    ((bf16_t*)(p.ws + WS_AA))[((size_t)r * 2 + d) * 512 + c] = f2bf(sigm(z));
  }
  }
}

DI void ph_attn(const PT& p) {
  const int lane = threadIdx.x & 63;
  const bf16_t* KN = (const bf16_t*)(p.ws + WS_KN);
  const bf16_t* KR = (const bf16_t*)(p.ws + WS_KR);
  for (int wv = (blockIdx.x * NTHR + threadIdx.x) >> 6; wv < NT * 8; wv += (gridDim.x * NTHR) >> 6) {
    int r = wv >> 3, h = wv & 7;
    RowInfo q = rinfo(r);
    bf16_t* Q = (bf16_t*)(p.ws + WS_Q) + (size_t)r * 768 + h * 96;
    unsigned qp[48];
#pragma unroll
    for (int d = 0; d < 48; ++d) qp[d] = ((const unsigned*)Q)[d];
    const bf16_t* VT = (const bf16_t*)(p.ws + WS_VT) + ((size_t)(q.b * 8 + h) * 64 + lane) * KEYS;
    float m = -1e30f, ls = 0.f, o = 0.f;
    for (int k0 = q.ctx ? SEQ : 0; k0 < KEYS; k0 += 64) {
      int kr = q.b * KEYS + k0 + lane;
      const unsigned* kn = (const unsigned*)(KN + ((size_t)kr * 8 + h) * 64);
      const unsigned* krp = (const unsigned*)(KR + (size_t)kr * 32);
      float s = 0.f;
#pragma unroll
      for (int d = 0; d < 32; ++d) { unsigned kq = kn[d]; s += __uint_as_float(qp[d] << 16) * __uint_as_float(kq << 16) + __uint_as_float(qp[d] & 0xffff0000u) * __uint_as_float(kq & 0xffff0000u); }
#pragma unroll
      for (int d = 0; d < 16; ++d) { unsigned kq = krp[d]; s += __uint_as_float(qp[32 + d] << 16) * __uint_as_float(kq << 16) + __uint_as_float(qp[32 + d] & 0xffff0000u) * __uint_as_float(kq & 0xffff0000u); }
      float mx = s;
#pragma unroll
      for (int off = 32; off > 0; off >>= 1) mx = fmaxf(mx, __shfl_xor(mx, off));
      float mn = fmaxf(m, mx);
      float al = expf(m - mn), pp = expf(s - mn);
      ls = ls * al + wave_sum(pp);
      o *= al; m = mn;
      for (int k = 0; k < 64; ++k) o += __shfl(pp, k) * bf2f(VT[k0 + k]);
    }
    Q[lane] = f2bf(o / ls);
  }
}

DI void ph_scan(const PT& p, int l) {
  if (blockIdx.x >= 128) return;
  int job = blockIdx.x >> 1, half = blockIdx.x & 1;
  int d = job & 1, h = (job >> 1) & 7, b = job >> 4;
  int w = threadIdx.x >> 6, lane = threadIdx.x & 63;
  int i = half * 32 + w * 4 + (lane >> 4), part = lane & 15;
  const bf16_t* P = (const bf16_t*)(p.ws + WS_P);
  const bf16_t* DEC = (const bf16_t*)(p.ws + WS_DEC);
  const bf16_t* AA = (const bf16_t*)(p.ws + WS_AA);
  bf16_t* YS = (bf16_t*)(p.ws + WS_BUFA) + (size_t)d * NT * 512;
  const float* mu = p.in[I_MU] + (size_t)l * 2 * RW_COLS;
  float kkw[4], kaw[4];
#pragma unroll
  for (int j = 0; j < 4; ++j) { kkw[j] = p.in[I_KK][l * 512 + h * 64 + part * 4 + j]; kaw[j] = p.in[I_KA][l * 512 + h * 64 + part * 4 + j]; }
  float S[4] = {0.f, 0.f, 0.f, 0.f};
  for (int step = 0; step < CTX + SEQ; ++step) {
    int r;
    if (step < CTX) { int t = d ? (CTX - 1 - step) : step; r = NLAT + b * CTX + t; }
    else { int s2 = step - CTX; int t = d ? (SEQ - 1 - s2) : s2; r = b * SEQ + t; }
    RowInfo q = rinfo(r);
    float rr[4], kraw[4], kk[4], aa[4], wd[4];
    float ss = 0.f;
#pragma unroll
    for (int j = 0; j < 4; ++j) {
      int c = h * 64 + part * 4 + j;
      rr[j] = ps_val(P, mu, r, q, c);
      kraw[j] = ps_val(P, mu, r, q, 512 + c);
      aa[j] = bf2f(AA[((size_t)r * 2 + d) * 512 + c]);
      wd[j] = expf(-bf2f(DEC[((size_t)r * 2 + d) * 512 + c]));
      kk[j] = kraw[j] * kkw[j]; ss += kk[j] * kk[j];
    }
    float vv = ps_val(P, mu, r, q, 1024 + h * 64 + i);
    ss = sum16(ss);
    float rn = rsqrtf(ss + 1e-12f);
    float sk = 0.f;
#pragma unroll
    for (int j = 0; j < 4; ++j) { kk[j] *= rn; sk += S[j] * kk[j]; }
    sk = sum16(sk);
    float y = 0.f;
#pragma unroll
    for (int j = 0; j < 4; ++j) {
      float keff = kraw[j] * (1.f + (aa[j] - 1.f) * kaw[j]);
      S[j] = S[j] * wd[j] - sk * (kk[j] * aa[j]) + vv * keff;
      y += S[j] * rr[j];
    }
    y = sum16(y);
    if (part == 0) YS[(size_t)r * 512 + h * 64 + i] = f2bf(y);
  }
}

DI void ph_rwkvout(const PT& p, int l) {
  const int lane = threadIdx.x & 63;
  for (int wv = (blockIdx.x * NTHR + threadIdx.x) >> 6; wv < NT * 8; wv += (gridDim.x * NTHR) >> 6) {
  int r = wv >> 3, h = wv & 7, c = h * 64 + lane;
  RowInfo q = rinfo(r);
  const bf16_t* P = (const bf16_t*)(p.ws + WS_P);
  const bf16_t* AA = (const bf16_t*)(p.ws + WS_AA);
  const bf16_t* YS = (const bf16_t*)(p.ws + WS_BUFA);
  const float* mu = p.in[I_MU] + (size_t)l * 2 * RW_COLS;
  float y = bf2f(YS[(size_t)r * 512 + c]) + bf2f(YS[(size_t)NT * 512 + (size_t)r * 512 + c]);
  float mean = wave_sum(y) * (1.f / 64.f);
  float dv = y - mean;
  float var = wave_sum(dv * dv) * (1.f / 64.f);
  float yn = dv * rsqrtf(var + 64e-5f) * p.in[I_LNG][l * 512 + c] + p.in[I_LNB][l * 512 + c];
  float rr = ps_val(P, mu, r, q, c), kraw = ps_val(P, mu, r, q, 512 + c), vv = ps_val(P, mu, r, q, 1024 + c);
  float ka = p.in[I_KA][l * 512 + c];
  float a0 = bf2f(AA[((size_t)r * 2 + 0) * 512 + c]), a1 = bf2f(AA[((size_t)r * 2 + 1) * 512 + c]);
  float keffsum = kraw * (1.f + (a0 - 1.f) * ka) + kraw * (1.f + (a1 - 1.f) * ka);
  float bonus = wave_sum(rr * keffsum * p.in[I_RK][l * 512 + c]);
  const float* g2 = p.in[I_G2] + (size_t)l * 160 * 512;
  float g = 0.f;
  for (int j = 0; j < 160; ++j) g += sigm(ps_val(P, mu, r, q, 1792 + j)) * g2[j * 512 + c];
  ((bf16_t*)(p.ws + WS_RW))[(size_t)r * 512 + c] = f2bf((yn + bonus * vv) * g);
  }
}

DI void ph_wout(const PT& p, int l) {
  for (long idx = (long)blockIdx.x * NTHR + threadIdx.x; idx < (long)NT * 1024; idx += (long)gridDim.x * NTHR) {
  int r = (int)(idx >> 10), n = (int)(idx & 1023);
  const bf16_t* Q = (const bf16_t*)(p.ws + WS_Q) + (size_t)r * 768;
  const bf16_t* RW = (const bf16_t*)(p.ws + WS_RW) + (size_t)r * 512;
  const float* W = p.in[I_WOUT] + (size_t)l * 1024 * 1024;
  float acc = 0.f;
  for (int k = 0; k < 512; ++k) acc += bf2f(Q[(k >> 6) * 96 + (k & 63)]) * W[(size_t)k * 1024 + n];
  for (int k = 0; k < 512; ++k) acc += bf2f(RW[k]) * W[(size_t)(512 + k) * 1024 + n];
  ((bf16_t*)(p.ws + WS_Y))[(size_t)r * 1024 + n] = f2bf(acc);
  }
}

DI void ph_postmix(const PT& p, int l) {
  const int lane = threadIdx.x & 63;
  for (int r = (blockIdx.x * NTHR + threadIdx.x) >> 6; r < NT; r += (gridDim.x * NTHR) >> 6) {
  RowInfo q = rinfo(r);
  const float* xin = q.ctx ? ((l == 0 ? p.in[I_CTX] : (const float*)(p.ws + WS_XC)) + (size_t)(r - NLAT) * D)
                           : ((l == 0 ? p.in[I_X] : (const float*)p.out) + (size_t)r * D);
  float* xout = q.ctx ? ((float*)(p.ws + WS_XC) + (size_t)(r - NLAT) * D) : (p.out + (size_t)r * D);
  const bf16_t* Y = (const bf16_t*)(p.ws + WS_Y) + (size_t)r * D;
  const float* mod = (const float*)(p.ws + WS_MOD) + (size_t)(l * 5 + modrow(q)) * 6144;
  float yv[16], xv[16]; float ss = 0.f;
#pragma unroll
  for (int i = 0; i < 16; ++i) { yv[i] = bf2f(Y[lane + 64 * i]); ss += yv[i] * yv[i]; }
  ss = wave_sum(ss);
  float rstd = rsqrtf(ss * (1.f / 1024.f) + EPS);
  const float* gpost = p.in[I_MIXPOST] + l * D;
  float s2 = 0.f;
#pragma unroll
  for (int i = 0; i < 16; ++i) { int k = lane + 64 * i; xv[i] = xin[k] + mod[2 * 1024 + k] * (yv[i] * rstd * gpost[k]); s2 += xv[i] * xv[i]; xout[k] = xv[i]; }
  s2 = wave_sum(s2);
  float rstd2 = rsqrtf(s2 * (1.f / 1024.f) + EPS);
  const float* gpre = p.in[I_FFNPRE] + l * D;
  bf16_t* H2 = (bf16_t*)(p.ws + WS_BUFA) + (size_t)r * D;
  const float* RWt = p.in[I_RW];
  float lg[16];
#pragma unroll
  for (int e = 0; e < 16; ++e) lg[e] = 0.f;
#pragma unroll
  for (int i = 0; i < 16; ++i) {
    int k = lane + 64 * i;
    float hv = xv[i] * rstd2 * gpre[k] * (1.f + mod[4 * 1024 + k]) + mod[3 * 1024 + k];
    H2[k] = f2bf(hv);
#pragma unroll
    for (int e = 0; e < 16; ++e) lg[e] += hv * RWt[k * 16 + e];
  }
#pragma unroll
  for (int e = 0; e < 16; ++e) lg[e] = wave_sum(lg[e]);
  if (lane == 0) {
    float sc[16], bi[16];
#pragma unroll
    for (int e = 0; e < 16; ++e) { sc[e] = sigm(lg[e]); bi[e] = sc[e] + p.in[I_RB][e]; }
    float bgs = -1e30f; int e1 = 0, e2 = 0; float w1 = 0.f, w2 = 0.f;
#pragma unroll
    for (int g = 0; g < 4; ++g) {
      float m1 = -1e30f, m2 = -1e30f, s1v = 0.f, s2v = 0.f; int i1 = 0, i2 = 0;
#pragma unroll
      for (int j = 0; j < 4; ++j) {
        float v = bi[g * 4 + j], s = sc[g * 4 + j];
        if (v > m1) { m2 = m1; i2 = i1; s2v = s1v; m1 = v; i1 = j; s1v = s; }
        else if (v > m2) { m2 = v; i2 = j; s2v = s; }
      }
      float gs = m1 + m2;
      if (gs > bgs) { bgs = gs; e1 = g * 4 + i1; e2 = g * 4 + i2; w1 = s1v; w2 = s2v; }
    }
    float inv = 1.f / (w1 + w2);
    int* CNT = (int*)(p.ws + WS_CTL) + l * 16;
    int* INV = (int*)(p.ws + WS_INV);
    int s1 = atomicAdd(&CNT[e1], 1), sl2 = atomicAdd(&CNT[e2], 1);
    INV[(size_t)e1 * NT + s1] = r; INV[(size_t)e2 * NT + sl2] = r;
    int* POS = (int*)(p.ws + WS_TOPK); float* GW = (float*)(p.ws + WS_TOPK + (size_t)NT * 8);
    POS[r * 2] = (e1 << 20) | s1; POS[r * 2 + 1] = (e2 << 20) | sl2;
    GW[r * 2] = w1 * inv; GW[r * 2 + 1] = w2 * inv;
  }
  }
}

DI int expert_off(const int* CNT, int e) { int a = 0; for (int t = 0; t < 16; ++t) a += (t < e) ? CNT[t] : 0; return a; }
DI void expert_of_row(const int* CNT, int sr, int& e, int& base) { int a = 0; e = 0; base = 0; for (int t = 0; t < 16; ++t) { if (sr >= a) { e = t; base = a; } a += CNT[t]; } }

DI void ph_moe_up(const PT& p, int l) {
  for (long idx = (long)blockIdx.x * NTHR + threadIdx.x; idx < (long)3 * NT * 256; idx += (long)gridDim.x * NTHR) {
  int row = (int)(idx >> 8), j = (int)(idx & 255);
  const bf16_t* H2 = (const bf16_t*)(p.ws + WS_BUFA);
  if (row < NT) {
    const bf16_t* h = H2 + (size_t)row * D;
    const float* wg = p.in[I_SG] + (size_t)l * 1024 * 256; const float* wu = p.in[I_SU] + (size_t)l * 1024 * 256;
    float g = 0.f, u = 0.f;
    for (int k = 0; k < 1024; ++k) { float hv = bf2f(h[k]); g += hv * wg[k * 256 + j]; u += hv * wu[k * 256 + j]; }
    ((bf16_t*)(p.ws + WS_ACTS))[(size_t)row * 256 + j] = f2bf(siluf(g) * u);
  } else {
    int sr = row - NT;
    const int* CNT = (const int*)(p.ws + WS_CTL) + l * 16;
    int e, base; expert_of_row(CNT, sr, e, base);
    int r = ((const int*)(p.ws + WS_INV))[(size_t)e * NT + (sr - base)];
    const bf16_t* h = H2 + (size_t)r * D;
    const float* wg = p.in[I_EG] + (size_t)(l * 16 + e) * 1024 * 256; const float* wu = p.in[I_EU] + (size_t)(l * 16 + e) * 1024 * 256;
    float g = 0.f, u = 0.f;
    for (int k = 0; k < 1024; ++k) { float hv = bf2f(h[k]); g += hv * wg[k * 256 + j]; u += hv * wu[k * 256 + j]; }
    ((bf16_t*)(p.ws + WS_ACTR))[(size_t)sr * 256 + j] = f2bf(siluf(g) * u);
  }
  }
}

DI void ph_moe_down(const PT& p, int l) {
  for (long idx = (long)blockIdx.x * NTHR + threadIdx.x; idx < (long)3 * NT * 1024; idx += (long)gridDim.x * NTHR) {
  int row = (int)(idx >> 10), n = (int)(idx & 1023);
  if (row < NT) {
    const bf16_t* a = (const bf16_t*)(p.ws + WS_ACTS) + (size_t)row * 256;
    const float* wd = p.in[I_SD] + (size_t)l * 256 * 1024;
    float acc = 0.f;
    for (int k = 0; k < 256; ++k) acc += bf2f(a[k]) * wd[k * 1024 + n];
    ((bf16_t*)(p.ws + WS_FS))[(size_t)row * 1024 + n] = f2bf(acc);
  } else {
    int sr = row - NT;
    const int* CNT = (const int*)(p.ws + WS_CTL) + l * 16;
    int e, base; expert_of_row(CNT, sr, e, base);
    const bf16_t* a = (const bf16_t*)(p.ws + WS_ACTR) + (size_t)sr * 256;
    const float* wd = p.in[I_ED] + (size_t)(l * 16 + e) * 256 * 1024;
    float acc = 0.f;
    for (int k = 0; k < 256; ++k) acc += bf2f(a[k]) * wd[k * 1024 + n];
    ((bf16_t*)(p.ws + WS_R))[(size_t)sr * 1024 + n] = f2bf(acc);
  }
  }
}

DI void ph_postffn(const PT& p, int l) {
  const int lane = threadIdx.x & 63;
  for (int r = (blockIdx.x * NTHR + threadIdx.x) >> 6; r < NT; r += (gridDim.x * NTHR) >> 6) {
  RowInfo q = rinfo(r);
  float* x = q.ctx ? ((float*)(p.ws + WS_XC) + (size_t)(r - NLAT) * D) : (p.out + (size_t)r * D);
  const int* CNT = (const int*)(p.ws + WS_CTL) + l * 16;
  const int* POS = (const int*)(p.ws + WS_TOPK); const float* GW = (const float*)(p.ws + WS_TOPK + (size_t)NT * 8);
  int p1 = POS[r * 2], p2 = POS[r * 2 + 1];
  size_t r1 = (size_t)(expert_off(CNT, p1 >> 20) + (p1 & 0xFFFFF)), r2 = (size_t)(expert_off(CNT, p2 >> 20) + (p2 & 0xFFFFF));
  float w1 = GW[r * 2], w2 = GW[r * 2 + 1];
  const bf16_t* FS = (const bf16_t*)(p.ws + WS_FS) + (size_t)r * D;
  const bf16_t* R1 = (const bf16_t*)(p.ws + WS_R) + r1 * D;
  const bf16_t* R2 = (const bf16_t*)(p.ws + WS_R) + r2 * D;
  const float* mod = (const float*)(p.ws + WS_MOD) + (size_t)(l * 5 + modrow(q)) * 6144;
  const float* g = p.in[I_FFNPOST] + l * D;
  float f[16]; float ss = 0.f;
#pragma unroll
  for (int i = 0; i < 16; ++i) { int k = lane + 64 * i; f[i] = bf2f(FS[k]) + w1 * bf2f(R1[k]) + w2 * bf2f(R2[k]); ss += f[i] * f[i]; }
  ss = wave_sum(ss);
  float rstd = rsqrtf(ss * (1.f / 1024.f) + EPS);
#pragma unroll
  for (int i = 0; i < 16; ++i) { int k = lane + 64 * i; x[k] = x[k] + mod[5 * 1024 + k] * (f[i] * rstd * g[k]); }
  }
}

__global__ void __launch_bounds__(NTHR) k_mega(Params pa) {
  cg::grid_group grid = cg::this_grid();
  if (threadIdx.x < 35) s_ptr[threadIdx.x] = (unsigned long long)pa.in[threadIdx.x];
  __syncthreads();
  PT p; p.out = pa.out; p.ws = pa.ws;
  ph_mod(p);
  grid.sync();
  for (int l = 0; l < DEPTH; ++l) {
    ph_prenorm(p, l);
    grid.sync();
    gemm_naive((const bf16_t*)(p.ws + WS_BUFA), 1024, p.in[I_WIN] + (size_t)l * 1024 * IN_COLS, IN_COLS, (bf16_t*)(p.ws + WS_P), IN_COLS, NT, IN_COLS, 1024);
    grid.sync();
    ph_mla(p, l);
    ph_lora(p, l);
    grid.sync();
    ph_attn(p);
    ph_scan(p, l);
    grid.sync();
    ph_rwkvout(p, l);
    grid.sync();
    ph_wout(p, l);
    grid.sync();
    ph_postmix(p, l);
    grid.sync();
    ph_moe_up(p, l);
    grid.sync();
    ph_moe_down(p, l);
    grid.sync();
    ph_postffn(p, l);
    grid.sync();
  }
}

extern "C" void kernel_launch(void* const* d_in, const int* in_sizes, int n_in, void* d_out, int out_size, void* d_ws, size_t ws_size,
                              hipStream_t stream) {
  static int grid_blocks = 0;
  if (!grid_blocks) {
    int dev = 0, cus = 0, per_cu = 0;
    (void)hipGetDevice(&dev);
    (void)hipDeviceGetAttribute(&cus, hipDeviceAttributeMultiprocessorCount, dev);
    (void)hipOccupancyMaxActiveBlocksPerMultiprocessor(&per_cu, (const void*)k_mega, NTHR, 0);
    if (per_cu < 1) per_cu = 1;
    grid_blocks = cus;
    if (ws_size < WS_END) fprintf(stderr, "kernel_launch: workspace too small: %zu < %zu\n", ws_size, (size_t)WS_END);
  }
  Params p{};
  for (int i = 0; i < 35; ++i) p.in[i] = (const float*)d_in[i];
  p.out = (float*)d_out; p.ws = (unsigned char*)d_ws;
  (void)hipMemsetAsync((char*)d_ws + WS_CTL, 0, 65536, stream);
  void* args[] = {&p};
  hipError_t e = hipLaunchCooperativeKernel((const void*)k_mega, dim3(grid_blocks), dim3(NTHR), args, 0, stream);
  if (e != hipSuccess) fprintf(stderr, "cooperative launch failed: %s (grid %d)\n", hipGetErrorString(e), grid_blocks);
}
```

```cpp
#include <hip/hip_runtime.h>
#include <hip/hip_cooperative_groups.h>
#include <stdint.h>
#include <stdio.h>
namespace cg = cooperative_groups;

#define DI __device__ __forceinline__
#define SC_DBL 0
#ifndef XM
#define XM 3
#endif
#ifndef SCX
#define SCX -1
#endif
#ifndef PROBE_PHASE
#define PROBE_PHASE -1
#endif
typedef unsigned short bf16_t;

constexpr int D = 1024, NB = 4, SEQ = 4096, CTX = 256, DEPTH = 2;
constexpr int NLAT = NB * SEQ;
constexpr int NCTX = NB * CTX;
constexpr int NT = NLAT + NCTX;
constexpr int KEYS = SEQ + CTX;
constexpr int HEADS = 8;
constexpr int IN_COLS = 2368, MLA_COLS = 416, RW_COLS = 1952;
constexpr int NEXP = 16;
constexpr int NTHR = 512;
constexpr float EPS = 1e-6f;
constexpr float QSCALE = 0.10206207261596577f;

constexpr size_t WS_CTL  = 0;
constexpr size_t WS_MOD  = 65536;
constexpr size_t WS_XC   = WS_MOD + 2 * 5 * 6144 * 4;
constexpr size_t WS_TOPK = WS_XC + (size_t)NCTX * D * 4;
constexpr size_t WS_INV  = WS_TOPK + (size_t)NT * 16;
constexpr size_t WS_BUFA = WS_INV + (size_t)NEXP * NT * 4;
constexpr size_t WS_P    = WS_BUFA + (size_t)NT * 1024 * 2;
constexpr size_t WS_Q    = WS_P + (size_t)NT * IN_COLS * 2;
constexpr size_t WS_KN   = WS_Q + (size_t)NT * 768 * 2;
constexpr size_t WS_VT   = WS_KN + (size_t)NT * 512 * 2;
constexpr size_t WS_DEC  = WS_VT + (size_t)NT * 512 * 2;
constexpr size_t WS_AA   = WS_DEC + (size_t)NT * 1024 * 2;
constexpr size_t WS_KR   = WS_AA + (size_t)NT * 1024 * 2;
constexpr size_t WS_END  = WS_KR + (size_t)NT * 32 * 2;
static_assert(WS_END <= (size_t)256 * 1024 * 1024, "workspace over 256 MiB");
constexpr size_t WS_Y    = WS_P;
constexpr size_t WS_ACTS = WS_P + (size_t)NT * 1024 * 2;
constexpr size_t WS_ACTR = WS_ACTS + (size_t)NT * 256 * 2;
constexpr size_t WS_FS   = WS_Q;
constexpr size_t WS_R    = WS_DEC;
constexpr size_t WS_RW   = WS_DEC;
static_assert(WS_ACTR + (size_t)2 * NT * 256 * 2 <= WS_Q, "act overflow");
static_assert(WS_FS + (size_t)NT * 1024 * 2 <= WS_DEC, "fs overflow");

struct Params {
  const float* in[35];
  float* out;
  unsigned char* ws;
};
__shared__ unsigned long long s_ptr[40];
__shared__ unsigned long long s_tc[2];
struct PT;
struct PT {
  struct In { DI const float* operator[](int i) const {
      unsigned long long v = s_ptr[i];
      unsigned lo = __builtin_amdgcn_readfirstlane((unsigned)v), hi = __builtin_amdgcn_readfirstlane((unsigned)(v >> 32));
      return (const float*)(const __attribute__((address_space(1))) float*)(((unsigned long long)hi << 32) | lo); } } in;
  float* out;
  unsigned char* ws;
};
DI int launder_v(int x) { asm volatile("" : "+v"(x)); return x; }
DI int launder_s(int x) { asm volatile("" : "+s"(x)); return x; }
DI PT launder(const PT& q) {
  unsigned long long o = (unsigned long long)q.out, w = (unsigned long long)q.ws;
  asm volatile("" : "+s"(o), "+s"(w));
  PT r; r.out = (float*)(__attribute__((address_space(1))) float*)o; r.ws = (unsigned char*)(__attribute__((address_space(1))) unsigned char*)w;
  return r;
}

enum { I_X = 0, I_C, I_CTX, I_CCTX, I_ADAW, I_ADAB, I_MIXPRE, I_MIXPOST, I_FFNPRE, I_FFNPOST, I_WIN, I_QNG, I_KVNG, I_WUQ, I_WUKV,
       I_MU, I_W0, I_W2, I_A0, I_A2, I_G2, I_KK, I_KA, I_RK, I_LNG, I_LNB, I_WOUT, I_RW, I_RB, I_EG, I_EU, I_ED, I_SG, I_SU, I_SD };

DI float bf2f(bf16_t h) { return __uint_as_float(((unsigned)h) << 16); }
typedef __attribute__((ext_vector_type(2))) float f32x2;
typedef __attribute__((ext_vector_type(2))) __bf16 bf16x2_t;
DI unsigned pack2(float a, float b) { f32x2 v = {a, b}; bf16x2_t r = __builtin_convertvector(v, bf16x2_t); return __builtin_bit_cast(unsigned, r); }
DI bf16_t f2bf(float x) { return (bf16_t)pack2(x, x); }
DI float frcp(float x) { return __builtin_amdgcn_rcpf(x); }
DI float sigm(float x) { return 1.f / (1.f + expf(-x)); }
DI float siluf(float x) { return x / (1.f + expf(-x)); }
template <int CTRL> DI float dpp_add(float v) { int t = __builtin_amdgcn_update_dpp(0, __float_as_int(v), CTRL, 0xf, 0xf, true); return v + __int_as_float(t); }
DI float sum16_dpp(float v) { v = dpp_add<0x128>(v); v = dpp_add<0x124>(v); v = dpp_add<0x122>(v); v = dpp_add<0x121>(v); return v; }
DI float rdlane(float v, int l) { return __int_as_float(__builtin_amdgcn_readlane(__float_as_int(v), l)); }
DI float wave_sum(float v) {
  v = sum16_dpp(v);
  return (rdlane(v, 0) + rdlane(v, 16)) + (rdlane(v, 32) + rdlane(v, 48));
}
DI float sum16(float v) {
#pragma unroll
  for (int o = 8; o > 0; o >>= 1) v += __shfl_xor(v, o);
  return v;
}

struct RowInfo { int b, t, len, ctx; };
DI RowInfo rinfo(int r) {
  RowInfo q;
  if (r < NLAT) { q.b = r >> 12; q.t = r & 4095; q.len = SEQ; q.ctx = 0; }
  else { int u = r - NLAT; q.b = u >> 8; q.t = u & 255; q.len = CTX; q.ctx = 1; }
  return q;
}
DI int keyidx(const RowInfo& q) { return q.ctx ? SEQ + q.t : q.t; }
DI int modrow(const RowInfo& q) { return q.ctx ? 4 : q.b; }

DI float ps_val(const bf16_t* P, const float* mu, int r, const RowInfo& q, int c) {
  size_t o = (size_t)r * IN_COLS + MLA_COLS + c;
  float pc = bf2f(P[o]);
  float pv = q.t > 0 ? bf2f(P[o - IN_COLS]) : 0.f;
  float nx = q.t < q.len - 1 ? bf2f(P[o + IN_COLS]) : 0.f;
  return pc + mu[c] * (pv - pc) + mu[RW_COLS + c] * (nx - pc);
}

DI void ph_mod(const PT& p_) {
  const PT p = launder(p_); const int TID = launder_v(threadIdx.x); const int BID = launder_s(blockIdx.x); (void)TID; (void)BID;
  for (int i = BID * NTHR + TID; i < DEPTH * 6144; i += gridDim.x * NTHR) {
  int l = i / 6144, n = i % 6144;
  const float* c = p.in[I_C]; const float* cc = p.in[I_CCTX];
  const float* W = p.in[I_ADAW] + (size_t)l * 1024 * 6144;
  float bias = p.in[I_ADAB][l * 6144 + n];
  float acc[5];
#pragma unroll
  for (int r = 0; r < 5; ++r) acc[r] = bias;
  for (int k = 0; k < 1024; ++k) {
    float w = W[(size_t)k * 6144 + n];
#pragma unroll
    for (int r = 0; r < 4; ++r) acc[r] += siluf(c[r * 1024 + k]) * w;
    acc[4] += siluf(cc[k]) * w;
  }
  float* MOD = (float*)(p.ws + WS_MOD);
#pragma unroll
  for (int r = 0; r < 5; ++r) MOD[(size_t)(l * 5 + r) * 6144 + n] = acc[r];
  }
}

DI void ph_prenorm(const PT& p_, int l) {
  const PT p = launder(p_); const int TID = launder_v(threadIdx.x); const int BID = launder_s(blockIdx.x); (void)TID; (void)BID;
  const int lane = TID & 63;
  for (int r = (BID * NTHR + TID) >> 6; r < NT; r += (gridDim.x * NTHR) >> 6) {
  RowInfo q = rinfo(r);
  const float* xrow = q.ctx ? ((l == 0 ? p.in[I_CTX] : (const float*)(p.ws + WS_XC)) + (size_t)(r - NLAT) * D)
                            : ((l == 0 ? p.in[I_X] : (const float*)p.out) + (size_t)r * D);
  float v[16]; float ss = 0.f;
#pragma unroll
  for (int i = 0; i < 16; ++i) { v[i] = xrow[lane + 64 * i]; ss += v[i] * v[i]; }
  ss = wave_sum(ss);
  float rstd = rsqrtf(ss * (1.f / 1024.f) + EPS);
  const float* g = p.in[I_MIXPRE] + l * D;
  const float* mod = (const float*)(p.ws + WS_MOD) + (size_t)(l * 5 + modrow(q)) * 6144;
  bf16_t* H = (bf16_t*)(p.ws + WS_BUFA) + (size_t)r * D;
#pragma unroll
  for (int i = 0; i < 16; ++i) { int k = lane + 64 * i; H[k] = f2bf(v[i] * rstd * g[k] * (1.f + mod[1024 + k]) + mod[k]); }
  }
}

DI void gemm_naive(const bf16_t* A, int lda, const float* W, int ldw, bf16_t* C, int ldc, int M, int N, int K) {
  const int TID = launder_v(threadIdx.x); const int BID = launder_s(blockIdx.x);
  for (long idx = (long)BID * NTHR + TID; idx < (long)M * N; idx += (long)gridDim.x * NTHR) {
  int r = (int)(idx / N), n = (int)(idx % N);
  const bf16_t* a = A + (size_t)r * lda;
  float acc = 0.f;
  for (int k = 0; k < K; ++k) acc += bf2f(a[k]) * W[(size_t)k * ldw + n];
  C[(size_t)r * ldc + n] = f2bf(acc);
  }
}

DI void rope_pair(float a1, float a2, int i, const RowInfo& q, float& o1, float& o2) {
  if (q.ctx) { o1 = a1; o2 = a2; return; }
  float pos = (float)((i < 8) ? (q.t >> 6) : (q.t & 63));
  float fr = __builtin_amdgcn_exp2f(-(float)(i & 7) * 1.6609640474436813f);
  float ang = pos * fr, c = __cosf(ang), s = __sinf(ang);
  o1 = a1 * c - a2 * s; o2 = a1 * s + a2 * c;
}
DI void ph_mla(const PT& p_, int l) {
  const PT p = launder(p_); const int TID = launder_v(threadIdx.x); const int BID = launder_s(blockIdx.x); (void)TID; (void)BID;
  for (long idx = (long)BID * NTHR + TID; idx < (long)NT * 1680; idx += (long)gridDim.x * NTHR) {
  int r = (int)(idx / 1680), j = (int)(idx % 1680);
  RowInfo q = rinfo(r);
  const bf16_t* prow = (const bf16_t*)(p.ws + WS_P) + (size_t)r * IN_COLS;
  bf16_t* Q = (bf16_t*)(p.ws + WS_Q) + (size_t)r * 768;
  int kr = q.b * KEYS + keyidx(q);
  if (j < 640) {
    int hh = j / 80, jj = j % 80;
    float ss = 0.f;
    for (int k = 0; k < 256; ++k) { float v = bf2f(prow[k]); ss += v * v; }
    float rs = rsqrtf(ss * (1.f / 256.f) + EPS);
    const float* gq = p.in[I_QNG] + l * 256; const float* W = p.in[I_WUQ] + (size_t)l * 256 * 768;
    if (jj < 64) {
      int n = hh * 96 + jj; float acc = 0.f;
      for (int k = 0; k < 256; ++k) acc += bf2f(prow[k]) * rs * gq[k] * W[k * 768 + n];
      Q[n] = f2bf(acc * QSCALE);
    } else {
      int i = jj - 64, n1 = hh * 96 + 64 + i, n2 = n1 + 16; float a1 = 0.f, a2 = 0.f;
      for (int k = 0; k < 256; ++k) { float v = bf2f(prow[k]) * rs * gq[k]; a1 += v * W[k * 768 + n1]; a2 += v * W[k * 768 + n2]; }
      float o1, o2; rope_pair(a1, a2, i, q, o1, o2);
      Q[n1] = f2bf(o1 * QSCALE); Q[n2] = f2bf(o2 * QSCALE);
    }
  } else if (j < 1664) {
    int n = j - 640, hh = n >> 7, jj = n & 127;
    float ss = 0.f;
    for (int k = 0; k < 128; ++k) { float v = bf2f(prow[256 + k]); ss += v * v; }
    float rs = rsqrtf(ss * (1.f / 128.f) + EPS);
    const float* gk = p.in[I_KVNG] + l * 128; const float* W = p.in[I_WUKV] + (size_t)l * 128 * 1024;
    float acc = 0.f;
    for (int k = 0; k < 128; ++k) acc += bf2f(prow[256 + k]) * rs * gk[k] * W[k * 1024 + n];
    if (jj < 64) ((bf16_t*)(p.ws + WS_KN))[((size_t)kr * 8 + hh) * 64 + jj] = f2bf(acc);
    else ((bf16_t*)(p.ws + WS_VT))[((size_t)(q.b * 8 + hh) * 64 + (jj - 64)) * KEYS + keyidx(q)] = f2bf(acc);
  } else {
    int i = j - 1664;
    float a1 = bf2f(prow[384 + i]), a2 = bf2f(prow[384 + 16 + i]), o1, o2;
    rope_pair(a1, a2, i, q, o1, o2);
    bf16_t* KR = (bf16_t*)(p.ws + WS_KR) + (size_t)kr * 32;
    KR[i] = f2bf(o1); KR[16 + i] = f2bf(o2);
  }
  }
}

DI void ph_lora(const PT& p_, int l) {
  const PT p = launder(p_); const int TID = launder_v(threadIdx.x); const int BID = launder_s(blockIdx.x); (void)TID; (void)BID;
  for (long idx = (long)BID * NTHR + TID; idx < (long)NT * 2048; idx += (long)gridDim.x * NTHR) {
  int r = (int)(idx >> 11), j = (int)(idx & 2047);
  int kind = j >> 9, c = j & 511;
  RowInfo q = rinfo(r);
  const bf16_t* P = (const bf16_t*)(p.ws + WS_P);
  const float* mu = p.in[I_MU] + (size_t)l * 2 * RW_COLS;
  if (kind < 2) {
    int d = kind;
    float z = p.in[I_W0][(l * 2 + d) * 512 + c];
    const float* w2 = p.in[I_W2] + (size_t)(l * 2 + d) * 64 * 512;
    for (int jj = 0; jj < 64; ++jj) z += tanhf(ps_val(P, mu, r, q, 1536 + d * 64 + jj)) * w2[jj * 512 + c];
    ((bf16_t*)(p.ws + WS_DEC))[((size_t)r * 2 + d) * 512 + c] = f2bf(0.6065306597126334f * sigm(z));
  } else {
    int d = kind - 2;
    float z = p.in[I_A0][(l * 2 + d) * 512 + c];
    const float* a2 = p.in[I_A2] + (size_t)(l * 2 + d) * 64 * 512;
    for (int jj = 0; jj < 64; ++jj) z += ps_val(P, mu, r, q, 1664 + d * 64 + jj) * a2[jj * 512 + c];
    ((bf16_t*)(p.ws + WS_AA))[((size_t)r * 2 + d) * 512 + c] = f2bf(sigm(z));
  }
  }
}

DI void ph_attn_naive(const PT& p_) {
  const PT p = launder(p_); const int TID = launder_v(threadIdx.x); const int BID = launder_s(blockIdx.x); (void)TID; (void)BID;
  const int lane = TID & 63;
  const bf16_t* KN = (const bf16_t*)(p.ws + WS_KN);
  const bf16_t* KR = (const bf16_t*)(p.ws + WS_KR);
  for (int wv = (BID * NTHR + TID) >> 6; wv < NT * 8; wv += (gridDim.x * NTHR) >> 6) {
    int r = wv >> 3, h = wv & 7;
    RowInfo q = rinfo(r);
    bf16_t* Q = (bf16_t*)(p.ws + WS_Q) + (size_t)r * 768 + h * 96;
    unsigned qp[48];
#pragma unroll
    for (int d = 0; d < 48; ++d) qp[d] = ((const unsigned*)Q)[d];
    const bf16_t* VT = (const bf16_t*)(p.ws + WS_VT) + ((size_t)(q.b * 8 + h) * 64 + lane) * KEYS;
    float m = -1e30f, ls = 0.f, o = 0.f;
    for (int k0 = q.ctx ? SEQ : 0; k0 < KEYS; k0 += 64) {
      int kr = q.b * KEYS + k0 + lane;
      const unsigned* kn = (const unsigned*)(KN + ((size_t)kr * 8 + h) * 64);
      const unsigned* krp = (const unsigned*)(KR + (size_t)kr * 32);
      float s = 0.f;
#pragma unroll
      for (int d = 0; d < 32; ++d) { unsigned kq = kn[d]; s += __uint_as_float(qp[d] << 16) * __uint_as_float(kq << 16) + __uint_as_float(qp[d] & 0xffff0000u) * __uint_as_float(kq & 0xffff0000u); }
#pragma unroll
      for (int d = 0; d < 16; ++d) { unsigned kq = krp[d]; s += __uint_as_float(qp[32 + d] << 16) * __uint_as_float(kq << 16) + __uint_as_float(qp[32 + d] & 0xffff0000u) * __uint_as_float(kq & 0xffff0000u); }
      float mx = s;
#pragma unroll
      for (int off = 32; off > 0; off >>= 1) mx = fmaxf(mx, __shfl_xor(mx, off));
      float mn = fmaxf(m, mx);
      float al = expf(m - mn), pp = expf(s - mn);
      ls = ls * al + wave_sum(pp);
      o *= al; m = mn;
      for (int k = 0; k < 64; ++k) o += __shfl(pp, k) * bf2f(VT[k0 + k]);
    }
    Q[lane] = f2bf(o / ls);
  }
}

DI void ph_scan_naive(const PT& p_, int l) {
  const PT p = launder(p_); const int TID = launder_v(threadIdx.x); const int BID = launder_s(blockIdx.x); (void)TID; (void)BID;
  if (BID >= 128) return;
  int job = BID >> 1, half = BID & 1;
  int d = job & 1, h = (job >> 1) & 7, b = job >> 4;
  int w = TID >> 6, lane = TID & 63;
  int i = half * 32 + w * 4 + (lane >> 4), part = lane & 15;
  const bf16_t* P = (const bf16_t*)(p.ws + WS_P);
  const bf16_t* DEC = (const bf16_t*)(p.ws + WS_DEC);
  const bf16_t* AA = (const bf16_t*)(p.ws + WS_AA);
  bf16_t* YS = (bf16_t*)(p.ws + WS_BUFA) + (size_t)d * NT * 512;
  const float* mu = p.in[I_MU] + (size_t)l * 2 * RW_COLS;
  float kkw[4], kaw[4];
#pragma unroll
  for (int j = 0; j < 4; ++j) { kkw[j] = p.in[I_KK][l * 512 + h * 64 + part * 4 + j]; kaw[j] = p.in[I_KA][l * 512 + h * 64 + part * 4 + j]; }
  float S[4] = {0.f, 0.f, 0.f, 0.f};
  for (int step = 0; step < CTX + SEQ; ++step) {
    int r;
    if (step < CTX) { int t = d ? (CTX - 1 - step) : step; r = NLAT + b * CTX + t; }
    else { int s2 = step - CTX; int t = d ? (SEQ - 1 - s2) : s2; r = b * SEQ + t; }
    RowInfo q = rinfo(r);
    float rr[4], kraw[4], kk[4], aa[4], wd[4];
    float ss = 0.f;
#pragma unroll
    for (int j = 0; j < 4; ++j) {
      int c = h * 64 + part * 4 + j;
      rr[j] = ps_val(P, mu, r, q, c);
      kraw[j] = ps_val(P, mu, r, q, 512 + c);
      aa[j] = bf2f(AA[((size_t)r * 2 + d) * 512 + c]);
      wd[j] = expf(-bf2f(DEC[((size_t)r * 2 + d) * 512 + c]));
      kk[j] = kraw[j] * kkw[j]; ss += kk[j] * kk[j];
    }
    float vv = ps_val(P, mu, r, q, 1024 + h * 64 + i);
    ss = sum16(ss);
    float rn = rsqrtf(ss + 1e-12f);
    float sk = 0.f;
#pragma unroll
    for (int j = 0; j < 4; ++j) { kk[j] *= rn; sk += S[j] * kk[j]; }
    sk = sum16(sk);
    float y = 0.f;
#pragma unroll
    for (int j = 0; j < 4; ++j) {
      float keff = kraw[j] * (1.f + (aa[j] - 1.f) * kaw[j]);
      S[j] = S[j] * wd[j] - sk * (kk[j] * aa[j]) + vv * keff;
      y += S[j] * rr[j];
    }
    y = sum16(y);
    if (part == 0) YS[(size_t)r * 512 + h * 64 + i] = f2bf(y);
  }
}

DI void ph_rwkvout(const PT& p_, int l) {
  const PT p = launder(p_); const int TID = launder_v(threadIdx.x); const int BID = launder_s(blockIdx.x); (void)TID; (void)BID;
  const int lane = TID & 63;
  for (int wv = (BID * NTHR + TID) >> 6; wv < NT * 8; wv += (gridDim.x * NTHR) >> 6) {
  int r = wv >> 3, h = wv & 7, c = h * 64 + lane;
  RowInfo q = rinfo(r);
  const bf16_t* P = (const bf16_t*)(p.ws + WS_P);
  const bf16_t* AA = (const bf16_t*)(p.ws + WS_AA);
  const bf16_t* YS = (const bf16_t*)(p.ws + WS_BUFA);
  const float* mu = p.in[I_MU] + (size_t)l * 2 * RW_COLS;
  float y = bf2f(YS[(size_t)r * 512 + c]) + bf2f(YS[(size_t)NT * 512 + (size_t)r * 512 + c]);
  float mean = wave_sum(y) * (1.f / 64.f);
  float dv = y - mean;
  float var = wave_sum(dv * dv) * (1.f / 64.f);
  float yn = dv * rsqrtf(var + 64e-5f) * p.in[I_LNG][l * 512 + c] + p.in[I_LNB][l * 512 + c];
  float rr = ps_val(P, mu, r, q, c), kraw = ps_val(P, mu, r, q, 512 + c), vv = ps_val(P, mu, r, q, 1024 + c);
  float ka = p.in[I_KA][l * 512 + c];
  float a0 = bf2f(AA[((size_t)r * 2 + 0) * 512 + c]), a1 = bf2f(AA[((size_t)r * 2 + 1) * 512 + c]);
  float keffsum = kraw * (1.f + (a0 - 1.f) * ka) + kraw * (1.f + (a1 - 1.f) * ka);
  float bonus = wave_sum(rr * keffsum * p.in[I_RK][l * 512 + c]);
  const float* g2 = p.in[I_G2] + (size_t)l * 160 * 512;
  float g = 0.f;
  for (int j = 0; j < 160; ++j) g += sigm(ps_val(P, mu, r, q, 1792 + j)) * g2[j * 512 + c];
  ((bf16_t*)(p.ws + WS_RW))[(size_t)r * 512 + c] = f2bf((yn + bonus * vv) * g);
  }
}

DI void ph_wout_naive(const PT& p_, int l) {
  const PT p = launder(p_); const int TID = launder_v(threadIdx.x); const int BID = launder_s(blockIdx.x); (void)TID; (void)BID;
  for (long idx = (long)BID * NTHR + TID; idx < (long)NT * 1024; idx += (long)gridDim.x * NTHR) {
  int r = (int)(idx >> 10), n = (int)(idx & 1023);
  const bf16_t* Q = (const bf16_t*)(p.ws + WS_Q) + (size_t)r * 768;
  const bf16_t* RW = (const bf16_t*)(p.ws + WS_RW) + (size_t)r * 512;
  const float* W = p.in[I_WOUT] + (size_t)l * 1024 * 1024;
  float acc = 0.f;
  for (int k = 0; k < 512; ++k) acc += bf2f(Q[(k >> 6) * 96 + (k & 63)]) * W[(size_t)k * 1024 + n];
  for (int k = 0; k < 512; ++k) acc += bf2f(RW[k]) * W[(size_t)(512 + k) * 1024 + n];
  ((bf16_t*)(p.ws + WS_Y))[(size_t)r * 1024 + n] = f2bf(acc);
  }
}

DI void ph_postmix(const PT& p_, int l) {
  const PT p = launder(p_); const int TID = launder_v(threadIdx.x); const int BID = launder_s(blockIdx.x); (void)TID; (void)BID;
  const int lane = TID & 63;
  for (int r = (BID * NTHR + TID) >> 6; r < NT; r += (gridDim.x * NTHR) >> 6) {
  RowInfo q = rinfo(r);
  const float* xin = q.ctx ? ((l == 0 ? p.in[I_CTX] : (const float*)(p.ws + WS_XC)) + (size_t)(r - NLAT) * D)
                           : ((l == 0 ? p.in[I_X] : (const float*)p.out) + (size_t)r * D);
  float* xout = q.ctx ? ((float*)(p.ws + WS_XC) + (size_t)(r - NLAT) * D) : (p.out + (size_t)r * D);
  const bf16_t* Y = (const bf16_t*)(p.ws + WS_Y) + (size_t)r * D;
  const float* mod = (const float*)(p.ws + WS_MOD) + (size_t)(l * 5 + modrow(q)) * 6144;
  float yv[16], xv[16]; float ss = 0.f;
#pragma unroll
  for (int i = 0; i < 16; ++i) { yv[i] = bf2f(Y[lane + 64 * i]); ss += yv[i] * yv[i]; }
  ss = wave_sum(ss);
  float rstd = rsqrtf(ss * (1.f / 1024.f) + EPS);
  const float* gpost = p.in[I_MIXPOST] + l * D;
  float s2 = 0.f;
#pragma unroll
  for (int i = 0; i < 16; ++i) { int k = lane + 64 * i; xv[i] = xin[k] + mod[2 * 1024 + k] * (yv[i] * rstd * gpost[k]); s2 += xv[i] * xv[i]; xout[k] = xv[i]; }
  s2 = wave_sum(s2);
  float rstd2 = rsqrtf(s2 * (1.f / 1024.f) + EPS);
  const float* gpre = p.in[I_FFNPRE] + l * D;
  bf16_t* H2 = (bf16_t*)(p.ws + WS_BUFA) + (size_t)r * D;
  const float* RWt = p.in[I_RW];
  float lg[16];
#pragma unroll
  for (int e = 0; e < 16; ++e) lg[e] = 0.f;
#pragma unroll
  for (int i = 0; i < 16; ++i) {
    int k = lane + 64 * i;
    float hv = xv[i] * rstd2 * gpre[k] * (1.f + mod[4 * 1024 + k]) + mod[3 * 1024 + k];
    H2[k] = f2bf(hv);
#pragma unroll
    for (int e = 0; e < 16; ++e) lg[e] += hv * RWt[k * 16 + e];
  }
#pragma unroll
  for (int e = 0; e < 16; ++e) lg[e] = wave_sum(lg[e]);
  if (lane == 0) {
    float sc[16], bi[16];
#pragma unroll
    for (int e = 0; e < 16; ++e) { sc[e] = sigm(lg[e]); bi[e] = sc[e] + p.in[I_RB][e]; }
    float bgs = -1e30f; int e1 = 0, e2 = 0; float w1 = 0.f, w2 = 0.f;
#pragma unroll
    for (int g = 0; g < 4; ++g) {
      float m1 = -1e30f, m2 = -1e30f, s1v = 0.f, s2v = 0.f; int i1 = 0, i2 = 0;
#pragma unroll
      for (int j = 0; j < 4; ++j) {
        float v = bi[g * 4 + j], s = sc[g * 4 + j];
        if (v > m1) { m2 = m1; i2 = i1; s2v = s1v; m1 = v; i1 = j; s1v = s; }
        else if (v > m2) { m2 = v; i2 = j; s2v = s; }
      }
      float gs = m1 + m2;
      if (gs > bgs) { bgs = gs; e1 = g * 4 + i1; e2 = g * 4 + i2; w1 = s1v; w2 = s2v; }
    }
    float inv = 1.f / (w1 + w2);
    int* CNT = (int*)(p.ws + WS_CTL) + l * 16;
    int* INV = (int*)(p.ws + WS_INV);
    int s1 = atomicAdd(&CNT[e1], 1), sl2 = atomicAdd(&CNT[e2], 1);
    INV[(size_t)e1 * NT + s1] = r; INV[(size_t)e2 * NT + sl2] = r;
    int* POS = (int*)(p.ws + WS_TOPK); float* GW = (float*)(p.ws + WS_TOPK + (size_t)NT * 8);
    POS[r * 2] = (e1 << 20) | s1; POS[r * 2 + 1] = (e2 << 20) | sl2;
    GW[r * 2] = w1 * inv; GW[r * 2 + 1] = w2 * inv;
  }
  }
}

DI int expert_off(const int* CNT, int e) { int a = 0; for (int t = 0; t < 16; ++t) a += (t < e) ? CNT[t] : 0; return a; }
DI void expert_of_row(const int* CNT, int sr, int& e, int& base) { int a = 0; e = 0; base = 0; for (int t = 0; t < 16; ++t) { if (sr >= a) { e = t; base = a; } a += CNT[t]; } }

DI void ph_moe_up_naive(const PT& p_, int l) {
  const PT p = launder(p_); const int TID = launder_v(threadIdx.x); const int BID = launder_s(blockIdx.x); (void)TID; (void)BID;
  for (long idx = (long)BID * NTHR + TID; idx < (long)3 * NT * 256; idx += (long)gridDim.x * NTHR) {
  int row = (int)(idx >> 8), j = (int)(idx & 255);
  const bf16_t* H2 = (const bf16_t*)(p.ws + WS_BUFA);
  if (row < NT) {
    const bf16_t* h = H2 + (size_t)row * D;
    const float* wg = p.in[I_SG] + (size_t)l * 1024 * 256; const float* wu = p.in[I_SU] + (size_t)l * 1024 * 256;
    float g = 0.f, u = 0.f;
    for (int k = 0; k < 1024; ++k) { float hv = bf2f(h[k]); g += hv * wg[k * 256 + j]; u += hv * wu[k * 256 + j]; }
    ((bf16_t*)(p.ws + WS_ACTS))[(size_t)row * 256 + j] = f2bf(siluf(g) * u);
  } else {
    int sr = row - NT;
    const int* CNT = (const int*)(p.ws + WS_CTL) + l * 16;
    int e, base; expert_of_row(CNT, sr, e, base);
    int r = ((const int*)(p.ws + WS_INV))[(size_t)e * NT + (sr - base)];
    const bf16_t* h = H2 + (size_t)r * D;
    const float* wg = p.in[I_EG] + (size_t)(l * 16 + e) * 1024 * 256; const float* wu = p.in[I_EU] + (size_t)(l * 16 + e) * 1024 * 256;
    float g = 0.f, u = 0.f;
    for (int k = 0; k < 1024; ++k) { float hv = bf2f(h[k]); g += hv * wg[k * 256 + j]; u += hv * wu[k * 256 + j]; }
    ((bf16_t*)(p.ws + WS_ACTR))[(size_t)sr * 256 + j] = f2bf(siluf(g) * u);
  }
  }
}

DI void ph_moe_down_naive(const PT& p_, int l) {
  const PT p = launder(p_); const int TID = launder_v(threadIdx.x); const int BID = launder_s(blockIdx.x); (void)TID; (void)BID;
  for (long idx = (long)BID * NTHR + TID; idx < (long)3 * NT * 1024; idx += (long)gridDim.x * NTHR) {
  int row = (int)(idx >> 10), n = (int)(idx & 1023);
  if (row < NT) {
    const bf16_t* a = (const bf16_t*)(p.ws + WS_ACTS) + (size_t)row * 256;
    const float* wd = p.in[I_SD] + (size_t)l * 256 * 1024;
    float acc = 0.f;
    for (int k = 0; k < 256; ++k) acc += bf2f(a[k]) * wd[k * 1024 + n];
    ((bf16_t*)(p.ws + WS_FS))[(size_t)row * 1024 + n] = f2bf(acc);
  } else {
    int sr = row - NT;
    const int* CNT = (const int*)(p.ws + WS_CTL) + l * 16;
    int e, base; expert_of_row(CNT, sr, e, base);
    const bf16_t* a = (const bf16_t*)(p.ws + WS_ACTR) + (size_t)sr * 256;
    const float* wd = p.in[I_ED] + (size_t)(l * 16 + e) * 256 * 1024;
    float acc = 0.f;
    for (int k = 0; k < 256; ++k) acc += bf2f(a[k]) * wd[k * 1024 + n];
    ((bf16_t*)(p.ws + WS_R))[(size_t)sr * 1024 + n] = f2bf(acc);
  }
  }
}

DI void ph_postffn(const PT& p_, int l) {
  const PT p = launder(p_); const int TID = launder_v(threadIdx.x); const int BID = launder_s(blockIdx.x); (void)TID; (void)BID;
  const int lane = TID & 63;
  for (int r = (BID * NTHR + TID) >> 6; r < NT; r += (gridDim.x * NTHR) >> 6) {
  RowInfo q = rinfo(r);
  float* x = q.ctx ? ((float*)(p.ws + WS_XC) + (size_t)(r - NLAT) * D) : (p.out + (size_t)r * D);
  const int* CNT = (const int*)(p.ws + WS_CTL) + l * 16;
  const int* POS = (const int*)(p.ws + WS_TOPK); const float* GW = (const float*)(p.ws + WS_TOPK + (size_t)NT * 8);
  int p1 = POS[r * 2], p2 = POS[r * 2 + 1];
  size_t r1 = (size_t)(expert_off(CNT, p1 >> 20) + (p1 & 0xFFFFF)), r2 = (size_t)(expert_off(CNT, p2 >> 20) + (p2 & 0xFFFFF));
  float w1 = GW[r * 2], w2 = GW[r * 2 + 1];
  const bf16_t* FS = (const bf16_t*)(p.ws + WS_FS) + (size_t)r * D;
  const bf16_t* R1 = (const bf16_t*)(p.ws + WS_R) + r1 * D;
  const bf16_t* R2 = (const bf16_t*)(p.ws + WS_R) + r2 * D;
  const float* mod = (const float*)(p.ws + WS_MOD) + (size_t)(l * 5 + modrow(q)) * 6144;
  const float* g = p.in[I_FFNPOST] + l * D;
  float f[16]; float ss = 0.f;
#pragma unroll
  for (int i = 0; i < 16; ++i) { int k = lane + 64 * i; f[i] = bf2f(FS[k]) + w1 * bf2f(R1[k]) + w2 * bf2f(R2[k]); ss += f[i] * f[i]; }
  ss = wave_sum(ss);
  float rstd = rsqrtf(ss * (1.f / 1024.f) + EPS);
#pragma unroll
  for (int i = 0; i < 16; ++i) { int k = lane + 64 * i; x[k] = x[k] + mod[5 * 1024 + k] * (f[i] * rstd * g[k]); }
  }
}


typedef __attribute__((ext_vector_type(8))) short bf16x8;
typedef __attribute__((ext_vector_type(4))) float f32x4;

constexpr int BM = 256, BN = 128, BK = 64, LDT = BK;
constexpr int GEMM_BUF = (BM + BN) * LDT;
constexpr int GEMM_LDS = 2 * GEMM_BUF * 2;

DI float sumsq8(const uint4& v) {
  float a = 0.f;
  const unsigned u[4] = {v.x, v.y, v.z, v.w};
#pragma unroll
  for (int i = 0; i < 4; ++i) { float lo = __uint_as_float(u[i] << 16), hi = __uint_as_float(u[i] & 0xffff0000u); a += lo * lo + hi * hi; }
  return a;
}
template <class Op>
DI void gemm_tile(const Op& op, unsigned char* smem, const int TID) {
  bf16_t* base = (bf16_t*)smem;
  const int tid = launder_v(TID), lane = tid & 63, w = tid >> 6, wm = w >> 1, wn = w & 1, l15 = lane & 15, g = lane >> 4;
  const int arow = tid >> 3, akc = tid & 7;
  const int bkg = ((tid >> 7) << 2) | (tid & 3), bng = (tid >> 2) & 31;
  f32x4 acc[4][4];
#pragma unroll
  for (int i = 0; i < 4; ++i)
#pragma unroll
    for (int j = 0; j < 4; ++j) acc[i][j] = (f32x4){0.f, 0.f, 0.f, 0.f};
  uint4 ra0[4], ra1[4]; float4 rb0[4], rb1[4];
  float ssq[4] = {0.f, 0.f, 0.f, 0.f};
  const int KT = op.K / BK;
#define G_LOAD(RA, RB, kt_) do { const int k0_ = (kt_) * BK; \
    _Pragma("unroll") for (int i = 0; i < 4; ++i) RA[i] = op.a_load(i, arow + 64 * i, k0_ + akc * 8); \
    _Pragma("unroll") for (int j = 0; j < 4; ++j) RB[j] = op.b_load(k0_ + bkg * 4 + j, bng * 4); } while (0)
#define G_STORE(RA, RB, buf_) do { bf16_t* As_ = base + (buf_) * GEMM_BUF; bf16_t* Bs_ = As_ + BM * LDT; \
    _Pragma("unroll") for (int i = 0; i < 4; ++i) { *(uint4*)(As_ + (arow + 64 * i) * LDT + ((akc ^ (((arow + 64 * i) >> 1) & 7)) * 8)) = RA[i]; if (Op::ROWSS) ssq[i] += sumsq8(RA[i]); } \
    _Pragma("unroll") for (int nn = 0; nn < 4; ++nn) { uint2 v_; v_.x = pack2(((const float*)&RB[0])[nn], ((const float*)&RB[1])[nn]); v_.y = pack2(((const float*)&RB[2])[nn], ((const float*)&RB[3])[nn]); \
      *(uint2*)(Bs_ + (bng * 4 + nn) * LDT + (((bkg >> 1) ^ (((bng * 4 + nn) >> 1) & 7)) * 8) + (bkg & 1) * 4) = v_; } } while (0)
#define G_COMPUTE(buf_) do { const bf16_t* As_ = base + (buf_) * GEMM_BUF; const bf16_t* Bs_ = As_ + BM * LDT; \
    _Pragma("unroll") for (int kk = 0; kk < 2; ++kk) { bf16x8 af[4], bfr[4]; \
      _Pragma("unroll") for (int i = 0; i < 4; ++i) af[i] = *(const bf16x8*)(As_ + (wm * 64 + i * 16 + l15) * LDT + (((kk * 4 + g) ^ (l15 >> 1)) * 8)); \
      _Pragma("unroll") for (int j = 0; j < 4; ++j) bfr[j] = *(const bf16x8*)(Bs_ + (wn * 64 + j * 16 + l15) * LDT + (((kk * 4 + g) ^ (l15 >> 1)) * 8)); \
      _Pragma("unroll") for (int i = 0; i < 4; ++i) _Pragma("unroll") for (int j = 0; j < 4; ++j) acc[i][j] = __builtin_amdgcn_mfma_f32_16x16x32_bf16(af[i], bfr[j], acc[i][j], 0, 0, 0); } } while (0)
  unsigned long long tg0 = 0, tg1 = 0;
  if (PROBE_PHASE >= 50 && PROBE_PHASE < 60) tg0 = __builtin_amdgcn_s_memrealtime();
  G_LOAD(ra0, rb0, 0);
  G_LOAD(ra1, rb1, min(1, KT - 1));
  G_STORE(ra0, rb0, 0);
  __syncthreads();
  for (int kt = 0; kt < KT; kt += 2) {
    G_LOAD(ra0, rb0, min(kt + 2, KT - 1));
    __builtin_amdgcn_sched_barrier(0);
    if (kt + 1 < KT) G_STORE(ra1, rb1, 1);
    G_COMPUTE(0);
    __syncthreads();
    if (kt + 1 >= KT) break;
    G_LOAD(ra1, rb1, min(kt + 3, KT - 1));
    __builtin_amdgcn_sched_barrier(0);
    if (kt + 2 < KT) G_STORE(ra0, rb0, 0);
    G_COMPUTE(1);
    __syncthreads();
  }
#undef G_LOAD
#undef G_STORE
#undef G_COMPUTE
  if (PROBE_PHASE >= 50 && PROBE_PHASE < 60) tg1 = __builtin_amdgcn_s_memrealtime();
  float* rowss = (float*)(smem + GEMM_LDS);
  if (Op::ROWSS) {
#pragma unroll
    for (int i = 0; i < 4; ++i) {
      float v = ssq[i];
      v += __shfl_xor(v, 1); v += __shfl_xor(v, 2); v += __shfl_xor(v, 4);
      if (akc == 0) rowss[arow + 64 * i] = v;
    }
    __syncthreads();
  }
#if defined(DBL_EPI)
  _Pragma("nounroll") for (int rep_ = 0; rep_ < launder_s(2); ++rep_)
#endif
  op.epilogue(acc, launder_v(wm), launder_v(wn), launder_v(l15), launder_v(g), rowss);
  if (Op::ROWSS) __syncthreads();
  if (PROBE_PHASE >= 50 && PROBE_PHASE < 60) {
    asm volatile("s_waitcnt vmcnt(0)" ::: "memory");
    const unsigned long long tg2 = __builtin_amdgcn_s_memrealtime();
    if (blockIdx.x == 0 && tid == 0) { s_tc[0] += tg1 - tg0; s_tc[1] += tg2 - tg1; }
  }
}

DI int rows_after_mixer(int l) { return (l + 1 < DEPTH) ? NT : NLAT; }
DI int vblock(int bid) { const int G = gridDim.x; return (G & 7) ? bid : (bid & 7) * (G >> 3) + (bid >> 3); }
DI void band_tile(int q, int TM, int TN, int MB, int& mt, int& nt) {
  const int per = MB * TN; const int band = q / per, rem = q - band * per; const int mb = min(MB, TM - band * MB);
  nt = rem / mb; mt = band * MB + (rem - nt * mb);
}
struct OpGemm1 {
  static constexpr bool ROWSS = false;
  static constexpr int K = 1024;
  const bf16_t* A; const float* W; bf16_t* C; int m0, n0;
  DI uint4 a_load(int i, int row, int k) const { return *(const uint4*)(A + (size_t)(m0 + row) * 1024 + k); }
  DI float4 b_load(int k, int n) const { int col = min(n0 + n, IN_COLS - 4); return *(const float4*)(W + (size_t)k * IN_COLS + col); }
  DI void epilogue(const f32x4 (&acc)[4][4], int wm, int wn, int l15, int g, const float* rowss) const {
#pragma unroll
    for (int i = 0; i < 4; ++i)
#pragma unroll
      for (int j = 0; j < 4; ++j) {
        int col = n0 + wn * 64 + j * 16 + l15;
        if (col < IN_COLS) {
#pragma unroll
          for (int r = 0; r < 4; ++r) C[(size_t)(m0 + wm * 64 + i * 16 + g * 4 + r) * IN_COLS + col] = f2bf(acc[i][j][r]);
        }
      }
  }
};
DI void ph_gemm1(const PT& p_, int l, unsigned char* smem) {
  const PT p = launder(p_); const int TID = launder_v(threadIdx.x); const int BID = launder_s(blockIdx.x); (void)TID; (void)BID;
  const bf16_t* A = (const bf16_t*)(p.ws + WS_BUFA); const float* W = p.in[I_WIN] + (size_t)l * 1024 * IN_COLS; bf16_t* C = (bf16_t*)(p.ws + WS_P);
  constexpr int TN = (IN_COLS + BN - 1) / BN, TM = NT / BM;
  for (int t = vblock(BID); t < TM * TN; t += gridDim.x) { int mt, nt; band_tile(t, TM, TN, 4, mt, nt); const OpGemm1 op{A, W, C, mt * BM, nt * BN}; gemm_tile(op, smem, TID); }
}

struct OpWout {
  static constexpr bool ROWSS = false;
  static constexpr int K = 1024;
  const bf16_t* Qb; const bf16_t* RWb; const float* W; bf16_t* C; int m0, n0;
  DI uint4 a_load(int i, int row, int k) const {
    size_t r = (size_t)(m0 + row);
    return k < 512 ? *(const uint4*)(Qb + r * 768 + (k >> 6) * 96 + (k & 63)) : *(const uint4*)(RWb + r * 512 + (k - 512));
  }
  DI float4 b_load(int k, int n) const { return *(const float4*)(W + (size_t)k * 1024 + n0 + n); }
  DI void epilogue(const f32x4 (&acc)[4][4], int wm, int wn, int l15, int g, const float* rowss) const {
#pragma unroll
    for (int i = 0; i < 4; ++i)
#pragma unroll
      for (int j = 0; j < 4; ++j) {
        int col = n0 + wn * 64 + j * 16 + l15;
#pragma unroll
        for (int r = 0; r < 4; ++r) C[(size_t)(m0 + wm * 64 + i * 16 + g * 4 + r) * 1024 + col] = f2bf(acc[i][j][r]);
      }
  }
};
DI void ph_wout(const PT& p_, int l, unsigned char* smem) {
  const PT p = launder(p_); const int TID = launder_v(threadIdx.x); const int BID = launder_s(blockIdx.x); (void)TID; (void)BID;
  const bf16_t* Qb = (const bf16_t*)(p.ws + WS_Q); const bf16_t* RWb = (const bf16_t*)(p.ws + WS_RW); const float* W = p.in[I_WOUT] + (size_t)l * 1024 * 1024; bf16_t* C = (bf16_t*)(p.ws + WS_Y);
  constexpr int TN = 1024 / BN; const int TM = rows_after_mixer(l) / BM;
  for (int t = vblock(BID); t < TM * TN; t += gridDim.x) { int mt, nt; band_tile(t, TM, TN, 4, mt, nt); const OpWout op{Qb, RWb, W, C, mt * BM, nt * BN}; gemm_tile(op, smem, TID); }
}

struct OpMoeUp {
  static constexpr bool ROWSS = false;
  static constexpr int K = 1024;
  const bf16_t* H2; const float* Wg; const float* Wu; bf16_t* C;
  int m0, nrows, jbase; size_t out_row0;
  int s0, s1, s2, s3;
  DI uint4 a_load(int i, int row, int k) const {
    int sr = i == 0 ? s0 : i == 1 ? s1 : i == 2 ? s2 : s3;
    return *(const uint4*)(H2 + (size_t)max(sr, 0) * 1024 + k);
  }
  DI float4 b_load(int k, int n) const {
    int j = jbase + (n >> 6) * 32 + ((n >> 4) & 1) * 16 + (n & 15);
    const float* W = ((n >> 5) & 1) ? Wu : Wg;
    return *(const float4*)(W + (size_t)k * 256 + j);
  }
  DI void epilogue(const f32x4 (&acc)[4][4], int wm, int wn, int l15, int g, const float* rowss) const {
#pragma unroll
    for (int i = 0; i < 4; ++i)
#pragma unroll
      for (int j = 0; j < 2; ++j) {
        int col = jbase + wn * 32 + j * 16 + l15;
#pragma unroll
        for (int r = 0; r < 4; ++r) {
          int lr = m0 + wm * 64 + i * 16 + g * 4 + r;
          if (lr < nrows) { float gv = acc[i][j][r], uv = acc[i][j + 2][r]; C[(out_row0 + lr) * 256 + col] = f2bf(gv * frcp(1.f + __expf(-gv)) * uv); }
        }
      }
  }
};
DI void ph_moe_up(const PT& p_, int l, unsigned char* smem) {
  const PT p = launder(p_); const int TID = launder_v(threadIdx.x); const int BID = launder_s(blockIdx.x); (void)TID; (void)BID;
  const int* CNT = (const int*)(p.ws + WS_CTL) + l * 16;
  constexpr int TNU = 4;
  const int NR = rows_after_mixer(l);
  const int shared_tiles = (NR / BM) * TNU;
  int tot = shared_tiles;
  for (int e = 0; e < 16; ++e) tot += ((CNT[e] + BM - 1) / BM) * TNU;
  const bf16_t* H2 = (const bf16_t*)(p.ws + WS_BUFA);
  const int* INVb = (const int*)(p.ws + WS_INV);
  const int arow = TID >> 3;
  for (int t = vblock(BID); t < tot; t += gridDim.x) {
    int e = -1, tb = 0, off = 0, at = shared_tiles, ar = 0;
    for (int q = 0; q < 16; ++q) { int c = CNT[q]; int nt = ((c + BM - 1) / BM) * TNU; if (t >= at && t < at + nt) { e = q; tb = at; off = ar; } at += nt; ar += c; }
    const bool sh = e < 0;
    const int lt = t - tb;
    const int m0 = (lt / TNU) * BM, nrows = sh ? NR : CNT[e];
    const size_t wo = sh ? (size_t)l * 1024 * 256 : (size_t)(l * 16 + e) * 1024 * 256;
    const float* Wg = (sh ? p.in[I_SG] : p.in[I_EG]) + wo;
    const float* Wu = (sh ? p.in[I_SU] : p.in[I_EU]) + wo;
    bf16_t* C = (bf16_t*)(p.ws + (sh ? WS_ACTS : WS_ACTR));
    const int* inv = INVb + (size_t)(sh ? 0 : e) * NT;
    int sr[4];
#pragma unroll
    for (int i = 0; i < 4; ++i) { int lr = m0 + arow + 64 * i; sr[i] = lr < nrows ? (sh ? lr : inv[lr]) : -1; }
    const OpMoeUp op{H2, Wg, Wu, C, m0, nrows, (lt % TNU) * 64, (size_t)off, sr[0], sr[1], sr[2], sr[3]};
    gemm_tile(op, smem, TID);
  }
}

struct OpMoeDown {
  static constexpr bool ROWSS = false;
  static constexpr int K = 256;
  const bf16_t* A; const float* W; bf16_t* C; int m0, nrows, n0; size_t row0;
  DI uint4 a_load(int i, int row, int k) const { int lr = min(m0 + row, nrows - 1); return *(const uint4*)(A + (row0 + lr) * 256 + k); }
  DI float4 b_load(int k, int n) const { return *(const float4*)(W + (size_t)k * 1024 + n0 + n); }
  DI void epilogue(const f32x4 (&acc)[4][4], int wm, int wn, int l15, int g, const float* rowss) const {
#pragma unroll
    for (int i = 0; i < 4; ++i)
#pragma unroll
      for (int j = 0; j < 4; ++j) {
        int col = n0 + wn * 64 + j * 16 + l15;
#pragma unroll
        for (int r = 0; r < 4; ++r) { int lr = m0 + wm * 64 + i * 16 + g * 4 + r; if (lr < nrows) C[(row0 + lr) * 1024 + col] = f2bf(acc[i][j][r]); }
      }
  }
};
DI void ph_moe_down(const PT& p_, int l, unsigned char* smem) {
  const PT p = launder(p_); const int TID = launder_v(threadIdx.x); const int BID = launder_s(blockIdx.x); (void)TID; (void)BID;
  const int* CNT = (const int*)(p.ws + WS_CTL) + l * 16;
  constexpr int TND = 1024 / BN;
  const int NR = rows_after_mixer(l);
  const int shared_tiles = (NR / BM) * TND;
  int tot = shared_tiles;
  for (int e = 0; e < 16; ++e) tot += ((CNT[e] + BM - 1) / BM) * TND;
  for (int t = vblock(BID); t < tot; t += gridDim.x) {
    int e = -1, tb = 0, off = 0, at = shared_tiles, ar = 0;
    for (int q = 0; q < 16; ++q) { int c = CNT[q]; int nt = ((c + BM - 1) / BM) * TND; if (t >= at && t < at + nt) { e = q; tb = at; off = ar; } at += nt; ar += c; }
    const bool sh = e < 0;
    const int lt = t - tb;
    const bf16_t* A = (const bf16_t*)(p.ws + (sh ? WS_ACTS : WS_ACTR));
    const float* W = sh ? p.in[I_SD] + (size_t)l * 256 * 1024 : p.in[I_ED] + (size_t)(l * 16 + e) * 256 * 1024;
    bf16_t* C = (bf16_t*)(p.ws + (sh ? WS_FS : WS_R));
    const OpMoeDown op{A, W, C, (lt / TND) * BM, sh ? NR : CNT[e], (lt % TND) * BN, (size_t)off};
    gemm_tile(op, smem, TID);
  }
}


constexpr int KS_LD = 104, VS_LD = 72;
constexpr int ATT_BUF = 64 * KS_LD + 64 * VS_LD;
constexpr int ATT_LDS = 2 * ATT_BUF * 2;
constexpr float LOG2E = 1.4426950408889634f;

DI void attn_item(const PT& p, unsigned char* smem, const int TID, int b, int h, int qrow0, int nw, int key0, int nkt) {
  bf16_t* base = (bf16_t*)smem;
  const int lane = TID & 63, w = TID >> 6, l15 = lane & 15, g = lane >> 4;
  const bool active = w < nw;
  bf16_t* Qg = (bf16_t*)(p.ws + WS_Q);
  const bf16_t* KN = (const bf16_t*)(p.ws + WS_KN);
  const bf16_t* KR = (const bf16_t*)(p.ws + WS_KR);
  const bf16_t* VT = (const bf16_t*)(p.ws + WS_VT) + (size_t)(b * 8 + h) * 64 * KEYS;
  bf16x8* qlds = (bf16x8*)(smem + ATT_LDS) + w * 12 * 64 + lane;
  if (active) {
#pragma unroll
    for (int qt = 0; qt < 4; ++qt)
#pragma unroll
      for (int ks = 0; ks < 3; ++ks)
        qlds[(qt * 3 + ks) * 64] = *(const bf16x8*)(Qg + (size_t)(qrow0 + w * 64 + qt * 16 + l15) * 768 + h * 96 + ks * 32 + g * 8);
  }
  f32x4 oacc[4][4];
#pragma unroll
  for (int i = 0; i < 4; ++i)
#pragma unroll
    for (int j = 0; j < 4; ++j) oacc[i][j] = (f32x4){0.f, 0.f, 0.f, 0.f};
  float mrun[4], lsum[4];
#pragma unroll
  for (int i = 0; i < 4; ++i) { mrun[i] = -1e30f; lsum[i] = 0.f; }
  const int skey = TID >> 3, sc8 = TID & 7;
  const int lrow = (skey & ~31) | (((skey >> 2) & 1) << 4) | (((skey >> 3) & 3) << 2) | (skey & 3);
  const int rkey = (TID & 255) >> 2, rc = TID & 3;
  const int rlrow = (rkey & ~31) | (((rkey >> 2) & 1) << 4) | (((rkey >> 3) & 3) << 2) | (rkey & 3);
  uint4 r_kn, r_kr, r_vt;
  r_kr = make_uint4(0u, 0u, 0u, 0u);
  {
    const size_t kr0 = (size_t)b * KEYS + key0;
    r_kn = *(const uint4*)(KN + ((kr0 + skey) * 8 + h) * 64 + sc8 * 8);
    if (TID < 256) r_kr = *(const uint4*)(KR + (kr0 + rkey) * 32 + rc * 8);
    r_vt = *(const uint4*)(VT + (size_t)skey * KEYS + key0 + sc8 * 8);
    bf16_t* Ks = base; bf16_t* Vs = base + 64 * KS_LD;
    *(uint4*)(Ks + lrow * KS_LD + sc8 * 8) = r_kn;
    if (TID < 256) *(uint4*)(Ks + rlrow * KS_LD + 64 + rc * 8) = r_kr;
    *(uint4*)(Vs + skey * VS_LD + sc8 * 8) = r_vt;
  }
  __syncthreads();
  for (int t = 0; t < nkt; ++t) {
    const bf16_t* Ks = base + (t & 1) * ATT_BUF; const bf16_t* Vs = Ks + 64 * KS_LD;
    const bool more = (t + 1 < nkt);
    if (more) {
      const int k0 = key0 + (t + 1) * 64;
      const size_t kr0 = (size_t)b * KEYS + k0;
      r_kn = *(const uint4*)(KN + ((kr0 + skey) * 8 + h) * 64 + sc8 * 8);
      if (TID < 256) r_kr = *(const uint4*)(KR + (kr0 + rkey) * 32 + rc * 8);
      r_vt = *(const uint4*)(VT + (size_t)skey * KEYS + k0 + sc8 * 8);
    }
    if (active) {
#pragma unroll 1
      for (int s2 = 0; s2 < 2; ++s2) {
        f32x4 sacc[2][4];
#pragma unroll
        for (int i = 0; i < 2; ++i)
#pragma unroll
          for (int j = 0; j < 4; ++j) sacc[i][j] = (f32x4){0.f, 0.f, 0.f, 0.f};
#pragma unroll
        for (int ks = 0; ks < 3; ++ks) {
          bf16x8 kf[2];
#pragma unroll
          for (int kt = 0; kt < 2; ++kt) kf[kt] = *(const bf16x8*)(Ks + ((2 * s2 + kt) * 16 + l15) * KS_LD + ks * 32 + g * 8);
#pragma unroll
          for (int qt = 0; qt < 4; ++qt) {
            const bf16x8 qf = qlds[(qt * 3 + ks) * 64];
#pragma unroll
            for (int kt = 0; kt < 2; ++kt) sacc[kt][qt] = __builtin_amdgcn_mfma_f32_16x16x32_bf16(kf[kt], qf, sacc[kt][qt], 0, 0, 0);
          }
        }
        bf16x8 vf[4];
#pragma unroll
        for (int vt = 0; vt < 4; ++vt) vf[vt] = *(const bf16x8*)(Vs + (vt * 16 + l15) * VS_LD + s2 * 32 + g * 8);
#pragma unroll
        for (int qt = 0; qt < 4; ++qt) {
          float mx = sacc[0][qt][0];
#pragma unroll
          for (int kt = 0; kt < 2; ++kt)
#pragma unroll
            for (int r = 0; r < 4; ++r) mx = fmaxf(mx, sacc[kt][qt][r]);
          mx = fmaxf(mx, __shfl_xor(mx, 16));
          mx = fmaxf(mx, __shfl_xor(mx, 32));
          const float mn = fmaxf(mrun[qt], mx * LOG2E);
          const float alpha = __builtin_amdgcn_exp2f(mrun[qt] - mn);
          mrun[qt] = mn;
          float ls = lsum[qt] * alpha;
#pragma unroll
          for (int vt = 0; vt < 4; ++vt) oacc[vt][qt] *= alpha;
#pragma unroll
          for (int kt = 0; kt < 2; ++kt)
#pragma unroll
            for (int r = 0; r < 4; ++r) { float pv = __builtin_amdgcn_exp2f(sacc[kt][qt][r] * LOG2E - mn); ls += pv; sacc[kt][qt][r] = pv; }
          lsum[qt] = ls;
          uint4 pk;
          pk.x = pack2(sacc[0][qt][0], sacc[0][qt][1]); pk.y = pack2(sacc[0][qt][2], sacc[0][qt][3]);
          pk.z = pack2(sacc[1][qt][0], sacc[1][qt][1]); pk.w = pack2(sacc[1][qt][2], sacc[1][qt][3]);
          const bf16x8 pf = __builtin_bit_cast(bf16x8, pk);
#pragma unroll
          for (int vt = 0; vt < 4; ++vt) oacc[vt][qt] = __builtin_amdgcn_mfma_f32_16x16x32_bf16(vf[vt], pf, oacc[vt][qt], 0, 0, 0);
        }
      }
    }
    if (more) {
      bf16_t* Ks2 = base + ((t + 1) & 1) * ATT_BUF; bf16_t* Vs2 = Ks2 + 64 * KS_LD;
      *(uint4*)(Ks2 + lrow * KS_LD + sc8 * 8) = r_kn;
      if (TID < 256) *(uint4*)(Ks2 + rlrow * KS_LD + 64 + rc * 8) = r_kr;
      *(uint4*)(Vs2 + skey * VS_LD + sc8 * 8) = r_vt;
    }
    __syncthreads();
  }
  if (active) {
#pragma unroll
    for (int qt = 0; qt < 4; ++qt) {
      float l = lsum[qt];
      l += __shfl_xor(l, 16); l += __shfl_xor(l, 32);
      const float inv = 1.f / l;
      bf16_t* orow = Qg + (size_t)(qrow0 + w * 64 + qt * 16 + l15) * 768 + h * 96;
#pragma unroll
      for (int vt = 0; vt < 4; ++vt) {
        uint2 o2; o2.x = pack2(oacc[vt][qt][0] * inv, oacc[vt][qt][1] * inv); o2.y = pack2(oacc[vt][qt][2] * inv, oacc[vt][qt][3] * inv);
        *(uint2*)(orow + vt * 16 + 4 * g) = o2;
      }
    }
  }
}
DI void ph_attn(const PT& p_, unsigned char* smem) {
  const PT p = launder(p_); const int TID = launder_v(threadIdx.x); const int BID = launder_s(blockIdx.x); (void)TID; (void)BID;
  for (int item = BID; item < 256 + 32; item += gridDim.x) {
    const bool lat = item < 256;
    const int bh = lat ? (item & 31) : (item - 256), qb = item >> 5;
    const int b = bh >> 3, h = bh & 7;
    attn_item(p, smem, TID, b, h, lat ? b * SEQ + qb * 512 : NLAT + b * CTX, lat ? 8 : 4, lat ? 0 : SEQ, lat ? KEYS / 64 : CTX / 64);
  }
}

constexpr int SC_CH = 32, SC_STEP = 392;
constexpr int SCAN_LDS = 2 * SC_CH * SC_STEP * 4;

DI int scan_row(int b, int d, int st) {
  if (st < CTX) { int t = d ? (CTX - 1 - st) : st; return NLAT + b * CTX + t; }
  int s2 = st - CTX; int t = d ? (SEQ - 1 - s2) : s2; return b * SEQ + t;
}
struct ScanRaw { unsigned pc[3], pv[3], nx[3], aa, dec; };
DI void scan_fetch(const bf16_t* P, const bf16_t* DEC, const bf16_t* AA, int b, int h, int d, int st0, int pw, int lane, ScanRaw (&raw)[4]) {
  const int half = lane >> 5, c0 = h * 64 + 2 * (lane & 31);
#pragma unroll
  for (int i = 0; i < 4; ++i) {
    const int r = scan_row(b, d, st0 + pw * 8 + 2 * i + half);
    const RowInfo q = rinfo(r);
    const bf16_t* pr = P + (size_t)r * IN_COLS + MLA_COLS + c0;
    const int op = q.t > 0 ? -IN_COLS : 0, on = q.t < q.len - 1 ? IN_COLS : 0;
#pragma unroll
    for (int j = 0; j < 3; ++j) { raw[i].pc[j] = *(const unsigned*)(pr + j * 512); raw[i].pv[j] = *(const unsigned*)(pr + j * 512 + op); raw[i].nx[j] = *(const unsigned*)(pr + j * 512 + on); }
    raw[i].aa = *(const unsigned*)(AA + ((size_t)r * 2 + d) * 512 + c0);
    raw[i].dec = *(const unsigned*)(DEC + ((size_t)r * 2 + d) * 512 + c0);
  }
}
DI float blo(unsigned u) { return __uint_as_float(u << 16); }
DI float bhi(unsigned u) { return __uint_as_float(u & 0xffff0000u); }
struct ScanConst { float m0[3][2], m1[3][2], kkw[2], kaw[2]; };
DI void scan_emit(const ScanRaw (&raw)[4], const ScanConst& K, int b, int d, int st0, int pw, int lane, float* buf) {
  const int half = lane >> 5, l2 = lane & 31;
#pragma unroll
  for (int i = 0; i < 4; ++i) {
    const int s = pw * 8 + 2 * i + half;
    const int r = scan_row(b, d, st0 + s);
    const RowInfo q = rinfo(r);
    const float mp = q.t > 0 ? 1.f : 0.f, mn = q.t < q.len - 1 ? 1.f : 0.f;
    float v[3][2];
#pragma unroll
    for (int j = 0; j < 3; ++j) {
      const float c0 = blo(raw[i].pc[j]), c1 = bhi(raw[i].pc[j]);
      v[j][0] = c0 + K.m0[j][0] * (mp * blo(raw[i].pv[j]) - c0) + K.m1[j][0] * (mn * blo(raw[i].nx[j]) - c0);
      v[j][1] = c1 + K.m0[j][1] * (mp * bhi(raw[i].pv[j]) - c1) + K.m1[j][1] * (mn * bhi(raw[i].nx[j]) - c1);
    }
    const float a0 = blo(raw[i].aa), a1 = bhi(raw[i].aa);
    const float w0 = __expf(-blo(raw[i].dec)), w1 = __expf(-bhi(raw[i].dec));
    float k0 = v[1][0] * K.kkw[0], k1 = v[1][1] * K.kkw[1];
    float ss = sum16_dpp(k0 * k0 + k1 * k1);
    const float ssA = rdlane(ss, 0) + rdlane(ss, 16), ssB = rdlane(ss, 32) + rdlane(ss, 48);
    const float rn = rsqrtf((half ? ssB : ssA) + 1e-12f);
    k0 *= rn; k1 *= rn;
    const float b0 = k0 * a0, b1 = k1 * a1;
    const float e0 = v[1][0] * (1.f + (a0 - 1.f) * K.kaw[0]), e1 = v[1][1] * (1.f + (a1 - 1.f) * K.kaw[1]);
    const float brs = sum16_dpp(b0 * v[0][0] + b1 * v[0][1]), krs = sum16_dpp(e0 * v[0][0] + e1 * v[0][1]);
    float* rec = buf + s * SC_STEP + 2 * l2;
    *(float2*)(rec) = make_float2(k0, k1); *(float2*)(rec + 64) = make_float2(w0, w1); *(float2*)(rec + 128) = make_float2(b0, b1);
    *(float2*)(rec + 192) = make_float2(e0, e1); *(float2*)(rec + 256) = make_float2(w0 * v[0][0], w1 * v[0][1]); *(float2*)(rec + 320) = make_float2(v[2][0], v[2][1]);
    const float brA = rdlane(brs, 0) + rdlane(brs, 16), brB = rdlane(brs, 32) + rdlane(brs, 48);
    const float krA = rdlane(krs, 0) + rdlane(krs, 16), krB = rdlane(krs, 32) + rdlane(krs, 48);
    if (l2 == 0) *(float2*)(buf + s * SC_STEP + 384) = make_float2(half ? brB : brA, half ? krB : krA);
  }
}
DI void ph_scan(const PT& p_, int l, unsigned char* smem) {
  const PT p = launder(p_); const int TID = launder_v(threadIdx.x); const int BID = launder_s(blockIdx.x); (void)TID; (void)BID;
  float* sbuf = (float*)smem;
  const int lane = TID & 63, w = TID >> 6;
  const bf16_t* P = (const bf16_t*)(p.ws + WS_P);
  const bf16_t* DEC = (const bf16_t*)(p.ws + WS_DEC);
  const bf16_t* AA = (const bf16_t*)(p.ws + WS_AA);
  for (int item = BID; item < 256; item += gridDim.x) {
    const int job = item >> 2, quarter = item & 3;
    const int d = job & 1, h = (job >> 1) & 7, b = job >> 4;
    constexpr int NCH = (CTX + SEQ) / SC_CH;
    if (w >= 4) {
      const int pw = w - 4, c0 = h * 64 + 2 * (lane & 31);
      const float* mu = p.in[I_MU] + (size_t)l * 2 * RW_COLS;
      ScanConst K;
#pragma unroll
      for (int j = 0; j < 3; ++j)
#pragma unroll
        for (int e = 0; e < 2; ++e) { K.m0[j][e] = mu[j * 512 + c0 + e]; K.m1[j][e] = mu[RW_COLS + j * 512 + c0 + e]; }
#pragma unroll
      for (int e = 0; e < 2; ++e) { K.kkw[e] = p.in[I_KK][l * 512 + c0 + e]; K.kaw[e] = p.in[I_KA][l * 512 + c0 + e]; }
      ScanRaw cur[4], nxt[4];
      scan_fetch(P, DEC, AA, b, h, d, 0, pw, lane, cur);
      scan_fetch(P, DEC, AA, b, h, d, SC_CH, pw, lane, nxt);
      scan_emit(cur, K, b, d, 0, pw, lane, sbuf);
      __syncthreads();
      for (int ch = 0; ch < NCH; ch += 2) {
        if (ch + 2 < NCH) scan_fetch(P, DEC, AA, b, h, d, (ch + 2) * SC_CH, pw, lane, cur);
        scan_emit(nxt, K, b, d, (ch + 1) * SC_CH, pw, lane, sbuf + SC_CH * SC_STEP);
        __syncthreads();
        if (ch + 3 < NCH) scan_fetch(P, DEC, AA, b, h, d, (ch + 3) * SC_CH, pw, lane, nxt);
        if (ch + 2 < NCH) scan_emit(cur, K, b, d, (ch + 2) * SC_CH, pw, lane, sbuf);
        __syncthreads();
      }
    } else {
      const int grow = lane >> 4, part = lane & 15;
      const int row = quarter * 16 + w * 4 + grow;
      bf16_t* YS = (bf16_t*)(p.ws + WS_BUFA) + (size_t)d * NT * 512 + h * 64 + row;
      float S0 = 0.f, S1 = 0.f, S2 = 0.f, S3 = 0.f;
      __builtin_amdgcn_s_setprio(3);
      __syncthreads();
      for (int ch = 0; ch < NCH; ++ch) {
        const float* cb = sbuf + (ch & 1) * SC_CH * SC_STEP;
        float4 kk = *(const float4*)(cb + part * 4), wd = *(const float4*)(cb + 64 + part * 4), bv = *(const float4*)(cb + 128 + part * 4);
        float4 ke = *(const float4*)(cb + 192 + part * 4), wr = *(const float4*)(cb + 256 + part * 4);
        float vv = cb[320 + row]; float2 sc = *(const float2*)(cb + 384);
        float ykeep = 0.f;
#pragma unroll
        for (int s = 0; s < SC_CH; ++s) {
          float4 nkk = kk, nwd = wd, nbv = bv, nke = ke, nwr = wr; float nvv = vv; float2 nsc = sc;
          if (s + 1 < SC_CH) {
            const float* rec = cb + (s + 1) * SC_STEP;
            nkk = *(const float4*)(rec + part * 4); nwd = *(const float4*)(rec + 64 + part * 4); nbv = *(const float4*)(rec + 128 + part * 4);
            nke = *(const float4*)(rec + 192 + part * 4); nwr = *(const float4*)(rec + 256 + part * 4);
            nvv = rec[320 + row]; nsc = *(const float2*)(rec + 384);
          }
          float d1 = S0 * kk.x + S1 * kk.y + (S2 * kk.z + S3 * kk.w);
          float d2 = S0 * wr.x + S1 * wr.y + (S2 * wr.z + S3 * wr.w);
          d1 = sum16_dpp(d1); d2 = sum16_dpp(d2);
          const float y = d2 - d1 * sc.x + vv * sc.y;
          S0 = S0 * wd.x + (vv * ke.x - d1 * bv.x);
          S1 = S1 * wd.y + (vv * ke.y - d1 * bv.y);
          S2 = S2 * wd.z + (vv * ke.z - d1 * bv.z);
          S3 = S3 * wd.w + (vv * ke.w - d1 * bv.w);
          ykeep = (part == (s & 15)) ? y : ykeep;
          if ((s & 15) == 15) YS[(size_t)scan_row(b, d, ch * SC_CH + (s - 15) + part) * 512] = f2bf(ykeep);
          kk = nkk; wd = nwd; bv = nbv; ke = nke; wr = nwr; vv = nvv; sc = nsc;
        }
        __syncthreads();
      }
      __builtin_amdgcn_s_setprio(0);
    }
  }
}

struct OpMlaQ {
  static constexpr bool ROWSS = true;
  static constexpr int K = 256;
  const bf16_t* P; const float* W; const float* gq; bf16_t* Q; int m0, n0;
  DI uint4 a_load(int i, int row, int k) const { return *(const uint4*)(P + (size_t)(m0 + row) * IN_COLS + k); }
  DI float4 b_load(int k, int n) const { float4 v = *(const float4*)(W + (size_t)k * 768 + n0 + n); float gk = gq[k]; v.x *= gk; v.y *= gk; v.z *= gk; v.w *= gk; return v; }
  DI void epilogue(const f32x4 (&acc)[4][4], int wm, int wn, int l15, int g, const float* rowss) const {
    const int sidx0 = (n0 >> 4) + wn * 4, m6 = sidx0 % 6;
    const int jr = m6 == 4 ? 0 : (m6 == 2 ? 2 : -1);
    const float fr = __builtin_amdgcn_exp2f(-(float)(l15 & 7) * 1.6609640474436813f);
#pragma unroll
    for (int i = 0; i < 4; ++i) {
#pragma unroll
      for (int r = 0; r < 4; ++r) {
        const int lrow = wm * 64 + i * 16 + g * 4 + r, row = m0 + lrow;
        const float rs = rsqrtf(rowss[lrow] * (1.f / 256.f) + EPS) * QSCALE;
        float v0 = acc[i][0][r] * rs, v1 = acc[i][1][r] * rs, v2 = acc[i][2][r] * rs, v3 = acc[i][3][r] * rs;
        if (jr >= 0 && row < NLAT) {
          const int t = row & 4095;
          const float ang = (float)((l15 < 8) ? (t >> 6) : (t & 63)) * fr;
          const float c = __cosf(ang), sn = __sinf(ang);
          if (jr == 0) { const float a1 = v0, a2 = v1; v0 = a1 * c - a2 * sn; v1 = a1 * sn + a2 * c; }
          else { const float a1 = v2, a2 = v3; v2 = a1 * c - a2 * sn; v3 = a1 * sn + a2 * c; }
        }
        bf16_t* qo = Q + (size_t)row * 768 + sidx0 * 16 + l15;
        qo[0] = f2bf(v0); qo[16] = f2bf(v1); qo[32] = f2bf(v2); qo[48] = f2bf(v3);
        __builtin_amdgcn_sched_barrier(0);
      }
    }
  }
};
struct OpMlaKV {
  static constexpr bool ROWSS = true;
  static constexpr int K = 128;
  const bf16_t* P; const float* W; const float* gk; bf16_t* KN; bf16_t* VT; int m0, n0;
  DI uint4 a_load(int i, int row, int k) const { return *(const uint4*)(P + (size_t)(m0 + row) * IN_COLS + 256 + k); }
  DI float4 b_load(int k, int n) const { float4 v = *(const float4*)(W + (size_t)k * 1024 + n0 + n); float g_ = gk[k]; v.x *= g_; v.y *= g_; v.z *= g_; v.w *= g_; return v; }
  DI void epilogue(const f32x4 (&acc)[4][4], int wm, int wn, int l15, int g, const float* rowss) const {
    const int hh = n0 >> 7;
#pragma unroll
    for (int i = 0; i < 4; ++i) {
      const int lrow0 = wm * 64 + i * 16 + g * 4;
      const RowInfo q = rinfo(m0 + lrow0);
      const int kidx0 = keyidx(q);
      float rs[4];
#pragma unroll
      for (int r = 0; r < 4; ++r) rs[r] = rsqrtf(rowss[lrow0 + r] * (1.f / 128.f) + EPS);
      if (wn == 0) {
#pragma unroll
        for (int r = 0; r < 4; ++r)
#pragma unroll
          for (int j = 0; j < 4; ++j) KN[(((size_t)q.b * KEYS + kidx0 + r) * 8 + hh) * 64 + j * 16 + l15] = f2bf(acc[i][j][r] * rs[r]);
      } else {
#pragma unroll
        for (int j = 0; j < 4; ++j) {
          uint2 o; o.x = pack2(acc[i][j][0] * rs[0], acc[i][j][1] * rs[1]); o.y = pack2(acc[i][j][2] * rs[2], acc[i][j][3] * rs[3]);
          *(uint2*)(VT + ((size_t)(q.b * 8 + hh) * 64 + j * 16 + l15) * KEYS + kidx0) = o;
        }
      }
    }
  }
};
DI void ps8(const bf16_t* P, const float* mu, int r, const RowInfo& q, int c, float (&o)[8]) {
  const size_t off = (size_t)r * IN_COLS + MLA_COLS + c;
  const uint4 pc = *(const uint4*)(P + off);
  const bool hp = q.t > 0, hn = q.t < q.len - 1;
  uint4 pv = *(const uint4*)(P + off - (hp ? IN_COLS : 0)), nx = *(const uint4*)(P + off + (hn ? IN_COLS : 0));
  if (!hp) pv = make_uint4(0u, 0u, 0u, 0u);
  if (!hn) nx = make_uint4(0u, 0u, 0u, 0u);
  const float4 m0a = *(const float4*)(mu + c), m0b = *(const float4*)(mu + c + 4), m1a = *(const float4*)(mu + RW_COLS + c), m1b = *(const float4*)(mu + RW_COLS + c + 4);
  const unsigned uc[4] = {pc.x, pc.y, pc.z, pc.w}, up[4] = {pv.x, pv.y, pv.z, pv.w}, un[4] = {nx.x, nx.y, nx.z, nx.w};
  const float m0[8] = {m0a.x, m0a.y, m0a.z, m0a.w, m0b.x, m0b.y, m0b.z, m0b.w}, m1[8] = {m1a.x, m1a.y, m1a.z, m1a.w, m1b.x, m1b.y, m1b.z, m1b.w};
#pragma unroll
  for (int i = 0; i < 4; ++i) {
    float c0 = __uint_as_float(uc[i] << 16), c1 = __uint_as_float(uc[i] & 0xffff0000u);
    float p0 = __uint_as_float(up[i] << 16), p1 = __uint_as_float(up[i] & 0xffff0000u);
    float n0 = __uint_as_float(un[i] << 16), n1 = __uint_as_float(un[i] & 0xffff0000u);
    o[2 * i] = c0 + m0[2 * i] * (p0 - c0) + m1[2 * i] * (n0 - c0);
    o[2 * i + 1] = c1 + m0[2 * i + 1] * (p1 - c1) + m1[2 * i + 1] * (n1 - c1);
  }
}
DI float tanh_fast(float x) { float e = __expf(2.f * x); return 1.f - 2.f * frcp(e + 1.f); }
struct OpLora {
  static constexpr bool ROWSS = false;
  static constexpr int K = 64;
  const bf16_t* P; const float* mu; const float* W; const float* bias; bf16_t* OUT; int m0, n0, d, kind;
  DI uint4 a_load(int i, int row, int k) const {
    const int r = m0 + row; const RowInfo q = rinfo(r);
    float v[8]; ps8(P, mu, r, q, (kind ? 1664 : 1536) + d * 64 + k, v);
    if (kind == 0) {
#pragma unroll
      for (int e = 0; e < 8; ++e) v[e] = tanh_fast(v[e]);
    }
    uint4 o; o.x = pack2(v[0], v[1]); o.y = pack2(v[2], v[3]); o.z = pack2(v[4], v[5]); o.w = pack2(v[6], v[7]);
    return o;
  }
  DI float4 b_load(int k, int n) const { return *(const float4*)(W + (size_t)k * 512 + n0 + n); }
  DI void epilogue(const f32x4 (&acc)[4][4], int wm, int wn, int l15, int g, const float* rowss) const {
#pragma unroll
    for (int j = 0; j < 4; ++j) {
      const int col = n0 + wn * 64 + j * 16 + l15;
      const float bs = bias[col];
#pragma unroll
      for (int i = 0; i < 4; ++i)
#pragma unroll
        for (int r = 0; r < 4; ++r) {
          const int row = m0 + wm * 64 + i * 16 + g * 4 + r;
          float sg = frcp(1.f + __expf(-(acc[i][j][r] + bs)));
          OUT[((size_t)row * 2 + d) * 512 + col] = f2bf(kind ? sg : 0.6065306597126334f * sg);
        }
    }
  }
};
DI int gcol(int c) { return c < 416 ? c : 1952 + (c - 416); }
struct OpGate {
  static constexpr bool ROWSS = false;
  static constexpr int K = 192;
  const bf16_t* P; const float* mu; const float* W; bf16_t* OUT; int m0, n0;
  DI uint4 a_load(int i, int row, int k) const {
    const int r = m0 + row; const RowInfo q = rinfo(r);
    float v[8]; ps8(P, mu, r, q, 1792 + min(k, 152), v);
#pragma unroll
    for (int e = 0; e < 8; ++e) v[e] = frcp(1.f + __expf(-v[e]));
    uint4 o; o.x = pack2(v[0], v[1]); o.y = pack2(v[2], v[3]); o.z = pack2(v[4], v[5]); o.w = pack2(v[6], v[7]);
    if (k >= 160) o = make_uint4(0u, 0u, 0u, 0u);
    return o;
  }
  DI float4 b_load(int k, int n) const { float4 v = *(const float4*)(W + (size_t)min(k, 159) * 512 + n0 + n); if (k >= 160) v = make_float4(0.f, 0.f, 0.f, 0.f); return v; }
  DI void epilogue(const f32x4 (&acc)[4][4], int wm, int wn, int l15, int g, const float* rowss) const {
#pragma unroll
    for (int i = 0; i < 4; ++i)
#pragma unroll
      for (int j = 0; j < 4; ++j)
#pragma unroll
        for (int r = 0; r < 4; ++r) OUT[(size_t)(m0 + wm * 64 + i * 16 + g * 4 + r) * IN_COLS + gcol(n0 + wn * 64 + j * 16 + l15)] = f2bf(acc[i][j][r]);
  }
};

DI void ld16f(const float* p, float (&v)[16]) {
#pragma unroll
  for (int i = 0; i < 4; ++i) { const float4 t = *(const float4*)(p + (i >> 1) * 512 + (i & 1) * 4); v[4 * i] = t.x; v[4 * i + 1] = t.y; v[4 * i + 2] = t.z; v[4 * i + 3] = t.w; }
}
DI void st16f(float* p, const float (&v)[16]) {
#pragma unroll
  for (int i = 0; i < 4; ++i) *(float4*)(p + (i >> 1) * 512 + (i & 1) * 4) = make_float4(v[4 * i], v[4 * i + 1], v[4 * i + 2], v[4 * i + 3]);
}
template <int O, int N> DI void unpack8o(const uint4& u, float (&v)[N]) {
  v[O + 0] = blo(u.x); v[O + 1] = bhi(u.x); v[O + 2] = blo(u.y); v[O + 3] = bhi(u.y); v[O + 4] = blo(u.z); v[O + 5] = bhi(u.z); v[O + 6] = blo(u.w); v[O + 7] = bhi(u.w);
}
DI void unpack8(const uint4& u, float (&v)[8]) { unpack8o<0, 8>(u, v); }
DI void ld16b(const bf16_t* p, float (&v)[16]) { const uint4 a = *(const uint4*)p, b = *(const uint4*)(p + 512); unpack8o<0, 16>(a, v); unpack8o<8, 16>(b, v); }
template <int O, int N> DI uint4 pack8o(const float (&v)[N]) { uint4 o; o.x = pack2(v[O + 0], v[O + 1]); o.y = pack2(v[O + 2], v[O + 3]); o.z = pack2(v[O + 4], v[O + 5]); o.w = pack2(v[O + 6], v[O + 7]); return o; }
DI uint4 pack8(const float (&v)[8]) { return pack8o<0, 8>(v); }
DI void st16b(bf16_t* p, const float (&v)[16]) { *(uint4*)p = pack8o<0, 16>(v); *(uint4*)(p + 512) = pack8o<8, 16>(v); }

DI void norm_mod_store(const float (&x)[16], const float* g, const float* shift, const float* scale, bf16_t* dst) {
  float ss = 0.f;
#pragma unroll
  for (int i = 0; i < 16; ++i) ss += x[i] * x[i];
  ss = wave_sum(ss);
  const float rstd = rsqrtf(ss * (1.f / 1024.f) + EPS);
  float gv[16], sh[16], sc[16], h[16];
  ld16f(g, gv); ld16f(shift, sh); ld16f(scale, sc);
#pragma unroll
  for (int i = 0; i < 16; ++i) h[i] = x[i] * rstd * gv[i] * (1.f + sc[i]) + sh[i];
  st16b(dst, h);
}
DI void ph_prenorm_v(const PT& p_, int l) {
  const PT p = launder(p_); const int TID = launder_v(threadIdx.x); const int BID = launder_s(blockIdx.x); (void)TID; (void)BID;
  const int lane = TID & 63, k0 = lane * 8;
  for (int r = (BID * NTHR + TID) >> 6; r < NT; r += (gridDim.x * NTHR) >> 6) {
    const RowInfo q = rinfo(r);
    const float* xrow = q.ctx ? ((l == 0 ? p.in[I_CTX] : (const float*)(p.ws + WS_XC)) + (size_t)(r - NLAT) * D)
                              : ((l == 0 ? p.in[I_X] : (const float*)p.out) + (size_t)r * D);
    float x[16]; ld16f(xrow + k0, x);
    const float* mod = (const float*)(p.ws + WS_MOD) + (size_t)(l * 5 + modrow(q)) * 6144;
    norm_mod_store(x, p.in[I_MIXPRE] + l * D + k0, mod + k0, mod + 1024 + k0, (bf16_t*)(p.ws + WS_BUFA) + (size_t)r * D + k0);
  }
}
DI void ph_postmix_v(const PT& p_, int l, unsigned char* smem) {
  const PT p = launder(p_); const int TID = launder_v(threadIdx.x); const int BID = launder_s(blockIdx.x); (void)TID; (void)BID;
  const int lane = TID & 63, k0 = lane * 8;
  float* wr = (float*)smem;
  for (int i = TID; i < 1024 * 16 / 4; i += NTHR) { const int k = i >> 2, e4 = i & 3; *(float4*)(wr + ((k & 511) >> 3) * 260 + ((k >> 9) * 8 + (k & 7)) * 16 + e4 * 4) = ((const float4*)p.in[I_RW])[i]; }
  int* lcnt = (int*)(smem + 68 * 1024);
  int* lbase = lcnt + 16;
  int* lrec = lcnt + 32;
  if (TID < 16) lcnt[TID] = 0;
  __syncthreads();
  int iter = 0;
  const int NR = rows_after_mixer(l);
  for (int r = (BID * NTHR + TID) >> 6; r < NR; r += (gridDim.x * NTHR) >> 6, ++iter) {
    const RowInfo q = rinfo(r);
    const float* xin = q.ctx ? ((l == 0 ? p.in[I_CTX] : (const float*)(p.ws + WS_XC)) + (size_t)(r - NLAT) * D)
                             : ((l == 0 ? p.in[I_X] : (const float*)p.out) + (size_t)r * D);
    float* xout = q.ctx ? ((float*)(p.ws + WS_XC) + (size_t)(r - NLAT) * D) : (p.out + (size_t)r * D);
    const float* mod = (const float*)(p.ws + WS_MOD) + (size_t)(l * 5 + modrow(q)) * 6144;
    float y[16], x[16];
    ld16b((const bf16_t*)(p.ws + WS_Y) + (size_t)r * D + k0, y);
    ld16f(xin + k0, x);
    float ss = 0.f;
#pragma unroll
    for (int i = 0; i < 16; ++i) ss += y[i] * y[i];
    ss = wave_sum(ss);
    const float rstd = rsqrtf(ss * (1.f / 1024.f) + EPS);
    {
      float gp[16], gt[16];
      ld16f(p.in[I_MIXPOST] + l * D + k0, gp); ld16f(mod + 2 * 1024 + k0, gt);
#pragma unroll
      for (int i = 0; i < 16; ++i) x[i] += gt[i] * (y[i] * rstd * gp[i]);
    }
    st16f(xout + k0, x);
    float s2 = 0.f;
#pragma unroll
    for (int i = 0; i < 16; ++i) s2 += x[i] * x[i];
    s2 = wave_sum(s2);
    const float rstd2 = rsqrtf(s2 * (1.f / 1024.f) + EPS);
    float h[16];
    {
      float gv[16], sh[16], sc[16];
      ld16f(p.in[I_FFNPRE] + l * D + k0, gv); ld16f(mod + 3 * 1024 + k0, sh); ld16f(mod + 4 * 1024 + k0, sc);
#pragma unroll
      for (int i = 0; i < 16; ++i) h[i] = x[i] * rstd2 * gv[i] * (1.f + sc[i]) + sh[i];
    }
    st16b((bf16_t*)(p.ws + WS_BUFA) + (size_t)r * D + k0, h);
    float lg[16];
#pragma unroll
    for (int e = 0; e < 16; ++e) lg[e] = 0.f;
#pragma unroll
    for (int j = 0; j < 16; ++j) {
      const float4* wrow = (const float4*)(wr + lane * 260 + j * 16);
#pragma unroll
      for (int e4 = 0; e4 < 4; ++e4) { const float4 wv = wrow[e4]; lg[4 * e4] += h[j] * wv.x; lg[4 * e4 + 1] += h[j] * wv.y; lg[4 * e4 + 2] += h[j] * wv.z; lg[4 * e4 + 3] += h[j] * wv.w; }
      if (j & 1) __builtin_amdgcn_sched_barrier(0);
    }
#pragma unroll
    for (int e = 0; e < 16; ++e) lg[e] = wave_sum(lg[e]);
    if (lane == 0) {
      float sc[16], bi[16];
      const float vz = __int_as_float(launder_v(0));
#pragma unroll
      for (int e = 0; e < 16; ++e) { sc[e] = frcp(1.f + __expf(-(lg[e] + vz))); bi[e] = sc[e] + p.in[I_RB][e]; }
      float bgs = -1e30f; int e1 = 0, e2 = 0; float w1 = 0.f, w2 = 0.f;
#pragma unroll
      for (int g = 0; g < 4; ++g) {
        float m1 = -1e30f, m2 = -1e30f, s1v = 0.f, s2v = 0.f; int i1 = 0, i2 = 0;
#pragma unroll
        for (int j = 0; j < 4; ++j) {
          const float v = bi[g * 4 + j], sv = sc[g * 4 + j];
          const bool g1 = v > m1, g2 = v > m2;
          m2 = g1 ? m1 : (g2 ? v : m2); i2 = g1 ? i1 : (g2 ? j : i2); s2v = g1 ? s1v : (g2 ? sv : s2v);
          m1 = g1 ? v : m1; i1 = g1 ? j : i1; s1v = g1 ? sv : s1v;
        }
        const float gs = m1 + m2;
        const bool better = gs > bgs;
        bgs = better ? gs : bgs; e1 = better ? g * 4 + i1 : e1; e2 = better ? g * 4 + i2 : e2; w1 = better ? s1v : w1; w2 = better ? s2v : w2;
      }
      const float inv = frcp(w1 + w2);
      const int li1 = atomicAdd(&lcnt[e1], 1), li2 = atomicAdd(&lcnt[e2], 1);
      int* rec = lrec + ((TID >> 6) * 16 + iter) * 8;
      rec[0] = r; rec[1] = e1; rec[2] = e2; rec[3] = li1; rec[4] = li2; rec[5] = __float_as_int(w1 * inv); rec[6] = __float_as_int(w2 * inv);
    }
  }
  __syncthreads();
  int* CNT = (int*)(p.ws + WS_CTL) + l * 16;
  if (TID < 16) lbase[TID] = atomicAdd(&CNT[TID], lcnt[TID]);
  __syncthreads();
  {
    const int wv = TID >> 4, it = TID & 15;
    int nit = 0;
    for (int r = (BID * NTHR + wv * 64) >> 6; r < NR; r += (gridDim.x * NTHR) >> 6) ++nit;
    if (TID < 128 && it < nit) {
      const int* rec = lrec + (wv * 16 + it) * 8;
      const int r = rec[0], e1 = rec[1], e2 = rec[2];
      const int s1 = lbase[e1] + rec[3], sl2 = lbase[e2] + rec[4];
      int* INV = (int*)(p.ws + WS_INV);
      INV[(size_t)e1 * NT + s1] = r; INV[(size_t)e2 * NT + sl2] = r;
      int* POS = (int*)(p.ws + WS_TOPK); float* GW = (float*)(p.ws + WS_TOPK + (size_t)NT * 8);
      POS[r * 2] = (e1 << 20) | s1; POS[r * 2 + 1] = (e2 << 20) | sl2;
      GW[r * 2] = __int_as_float(rec[5]); GW[r * 2 + 1] = __int_as_float(rec[6]);
    }
  }
  __syncthreads();
}
DI void ph_postffn_v(const PT& p_, int l) {
  const PT p = launder(p_); const int TID = launder_v(threadIdx.x); const int BID = launder_s(blockIdx.x); (void)TID; (void)BID;
  const int lane = TID & 63, k0 = lane * 8;
  const int* CNT = (const int*)(p.ws + WS_CTL) + l * 16;
  const int NR = rows_after_mixer(l);
  for (int r = (BID * NTHR + TID) >> 6; r < NR; r += (gridDim.x * NTHR) >> 6) {
    const RowInfo q = rinfo(r);
    float* xp = q.ctx ? ((float*)(p.ws + WS_XC) + (size_t)(r - NLAT) * D) : (p.out + (size_t)r * D);
    const int* POS = (const int*)(p.ws + WS_TOPK); const float* GW = (const float*)(p.ws + WS_TOPK + (size_t)NT * 8);
    const int p1 = POS[r * 2], p2 = POS[r * 2 + 1];
    const size_t r1 = (size_t)(expert_off(CNT, p1 >> 20) + (p1 & 0xFFFFF)), r2 = (size_t)(expert_off(CNT, p2 >> 20) + (p2 & 0xFFFFF));
    const float w1 = GW[r * 2], w2 = GW[r * 2 + 1];
    float f[16], a[16], b2[16], x[16];
    ld16b((const bf16_t*)(p.ws + WS_FS) + (size_t)r * D + k0, f);
    ld16b((const bf16_t*)(p.ws + WS_R) + r1 * D + k0, a);
    ld16b((const bf16_t*)(p.ws + WS_R) + r2 * D + k0, b2);
    ld16f(xp + k0, x);
    const float* mod = (const float*)(p.ws + WS_MOD) + (size_t)(l * 5 + modrow(q)) * 6144;
    float ss = 0.f;
#pragma unroll
    for (int i = 0; i < 16; ++i) { f[i] += w1 * a[i] + w2 * b2[i]; ss += f[i] * f[i]; }
    ss = wave_sum(ss);
    const float rstd = rsqrtf(ss * (1.f / 1024.f) + EPS);
    {
      float gp[16], gt[16];
      ld16f(p.in[I_FFNPOST] + l * D + k0, gp); ld16f(mod + 5 * 1024 + k0, gt);
#pragma unroll
      for (int i = 0; i < 16; ++i) x[i] += gt[i] * (f[i] * rstd * gp[i]);
    }
    st16f(xp + k0, x);
    if (l + 1 < DEPTH) {
      const float* mod2 = (const float*)(p.ws + WS_MOD) + (size_t)((l + 1) * 5 + modrow(q)) * 6144;
      norm_mod_store(x, p.in[I_MIXPRE] + (l + 1) * D + k0, mod2 + k0, mod2 + 1024 + k0, (bf16_t*)(p.ws + WS_BUFA) + (size_t)r * D + k0);
    }
  }
}
template <int CTRL> DI float dpp_mov_add(float v) { int t = __builtin_amdgcn_update_dpp(0, __float_as_int(v), CTRL, 0xf, 0xf, true); return v + __int_as_float(t); }
DI float sum8_dpp(float v) { v = dpp_mov_add<0xB1>(v); v = dpp_mov_add<0x4E>(v); v = dpp_mov_add<0x141>(v); return v; }
DI void ph_rwkvout_v(const PT& p_, int l) {
  const PT p = launder(p_); const int TID = launder_v(threadIdx.x); const int BID = launder_s(blockIdx.x); (void)TID; (void)BID;
  const int lane = TID & 63, c0 = lane * 8;
  const bf16_t* P = (const bf16_t*)(p.ws + WS_P);
  const bf16_t* AA = (const bf16_t*)(p.ws + WS_AA);
  const bf16_t* YS = (const bf16_t*)(p.ws + WS_BUFA);
  const float* mu = p.in[I_MU] + (size_t)l * 2 * RW_COLS;
  float lg[8], lb[8], rk[8], ka[8];
#pragma unroll
  for (int i = 0; i < 8; ++i) { lg[i] = p.in[I_LNG][l * 512 + c0 + i]; lb[i] = p.in[I_LNB][l * 512 + c0 + i]; rk[i] = p.in[I_RK][l * 512 + c0 + i]; ka[i] = p.in[I_KA][l * 512 + c0 + i]; }
  const int NR = rows_after_mixer(l);
  for (int r = (BID * NTHR + TID) >> 6; r < NR; r += (gridDim.x * NTHR) >> 6) {
    const RowInfo q = rinfo(r);
    float y0[8], y1[8], rr[8], kr[8], vv[8], a0[8], a1[8], gg[8];
    { const uint4 u = *(const uint4*)(YS + (size_t)r * 512 + c0); unpack8(u, y0); }
    { const uint4 u = *(const uint4*)(YS + (size_t)NT * 512 + (size_t)r * 512 + c0); unpack8(u, y1); }
    ps8(P, mu, r, q, c0, rr); ps8(P, mu, r, q, 512 + c0, kr); ps8(P, mu, r, q, 1024 + c0, vv);
    { const uint4 u = *(const uint4*)(AA + ((size_t)r * 2 + 0) * 512 + c0); unpack8(u, a0); }
    { const uint4 u = *(const uint4*)(AA + ((size_t)r * 2 + 1) * 512 + c0); unpack8(u, a1); }
    { const uint4 u = *(const uint4*)(P + (size_t)r * IN_COLS + gcol(c0)); unpack8(u, gg); }
    float sy = 0.f, sb = 0.f;
#pragma unroll
    for (int i = 0; i < 8; ++i) { y0[i] += y1[i]; sy += y0[i]; const float ke = kr[i] * (2.f + (a0[i] + a1[i] - 2.f) * ka[i]); sb += rr[i] * ke * rk[i]; }
    const float mean = sum8_dpp(sy) * (1.f / 64.f), bonus = sum8_dpp(sb);
    float sv = 0.f;
#pragma unroll
    for (int i = 0; i < 8; ++i) { y0[i] -= mean; sv += y0[i] * y0[i]; }
    const float rs = rsqrtf(sum8_dpp(sv) * (1.f / 64.f) + 64e-5f);
    float o[8];
#pragma unroll
    for (int i = 0; i < 8; ++i) o[i] = (y0[i] * rs * lg[i] + lb[i] + bonus * vv[i]) * gg[i];
    *(uint4*)((bf16_t*)(p.ws + WS_RW) + (size_t)r * 512 + c0) = pack8(o);
  }
}
constexpr size_t WS_G = WS_KN;

DI void ph_mla_lora(const PT& p_, int l, unsigned char* smem) {
  const PT p = launder(p_); const int TID = launder_v(threadIdx.x); const int BID = launder_s(blockIdx.x); (void)TID; (void)BID;
  const bf16_t* P = (const bf16_t*)(p.ws + WS_P);
  constexpr int TM = NT / BM;
  constexpr int T_Q = TM * 6, T_KV = TM * 8, T_LORA = TM * 16;
  const float* mu = p.in[I_MU] + (size_t)l * 2 * RW_COLS;
  for (int t = vblock(BID); t < T_Q + T_KV + T_LORA; t += gridDim.x) {
    if (t < T_Q) {
      int mt, nt; band_tile(t, TM, 6, 4, mt, nt);
      const OpMlaQ op{P, p.in[I_WUQ] + (size_t)l * 256 * 768, p.in[I_QNG] + l * 256, (bf16_t*)(p.ws + WS_Q), mt * BM, nt * BN};
      gemm_tile(op, smem, TID);
    } else if (t < T_Q + T_KV) {
      int mt, nt; band_tile(t - T_Q, TM, 8, 4, mt, nt);
      const OpMlaKV op{P, p.in[I_WUKV] + (size_t)l * 128 * 1024, p.in[I_KVNG] + l * 128, (bf16_t*)(p.ws + WS_KN), (bf16_t*)(p.ws + WS_VT), mt * BM, nt * BN};
      gemm_tile(op, smem, TID);
    } else {
      int mt, v; band_tile(t - T_Q - T_KV, TM, 16, 2, mt, v);
      const int kind = v >> 3, d = (v >> 2) & 1, nt = v & 3;
      const float* W = (kind ? p.in[I_A2] : p.in[I_W2]) + (size_t)(l * 2 + d) * 64 * 512;
      const float* bias = (kind ? p.in[I_A0] : p.in[I_W0]) + (l * 2 + d) * 512;
      const OpLora op{P, mu, W, bias, (bf16_t*)(p.ws + (kind ? WS_AA : WS_DEC)), mt * BM, nt * BN, d, kind};
      gemm_tile(op, smem, TID);
    }
  }
  for (int idx = BID * NTHR + TID; idx < NT * 16; idx += gridDim.x * NTHR) {
    const int r = idx >> 4, i = idx & 15;
    const RowInfo q = rinfo(r);
    const bf16_t* prow = P + (size_t)r * IN_COLS;
    float a1 = bf2f(prow[384 + i]), a2 = bf2f(prow[384 + 16 + i]), o1, o2;
    rope_pair(a1, a2, i, q, o1, o2);
    bf16_t* KR = (bf16_t*)(p.ws + WS_KR) + ((size_t)q.b * KEYS + keyidx(q)) * 32;
    KR[i] = f2bf(o1); KR[16 + i] = f2bf(o2);
  }
}
DI void ph_gate(const PT& p_, int l, unsigned char* smem) {
  const PT p = launder(p_); const int TID = launder_v(threadIdx.x); const int BID = launder_s(blockIdx.x); (void)TID; (void)BID;
  constexpr int TM = NT / BM;
  const float* mu = p.in[I_MU] + (size_t)l * 2 * RW_COLS;
  for (int t = vblock(BID); t < TM * 4; t += gridDim.x) {
    int mt, nt; band_tile(t, TM, 4, 8, mt, nt);
    const OpGate op{(const bf16_t*)(p.ws + WS_P), mu, p.in[I_G2] + (size_t)l * 160 * 512, (bf16_t*)(p.ws + WS_P), mt * BM, nt * BN};
    gemm_tile(op, smem, TID);
  }
}
DI void ph_rwkvout2(const PT& p_, int l) {
  const PT p = launder(p_); const int TID = launder_v(threadIdx.x); const int BID = launder_s(blockIdx.x); (void)TID; (void)BID;
  const int lane = TID & 63;
  const bf16_t* P = (const bf16_t*)(p.ws + WS_P);
  const bf16_t* AA = (const bf16_t*)(p.ws + WS_AA);
  const bf16_t* YS = (const bf16_t*)(p.ws + WS_BUFA);
  const bf16_t* G = (const bf16_t*)(p.ws + WS_G);
  const float* mu = p.in[I_MU] + (size_t)l * 2 * RW_COLS;
  for (int wv = (BID * NTHR + TID) >> 6; wv < NT * 8; wv += (gridDim.x * NTHR) >> 6) {
    const int r = wv >> 3, h = wv & 7, c = h * 64 + lane;
    const RowInfo q = rinfo(r);
    float y = bf2f(YS[(size_t)r * 512 + c]) + bf2f(YS[(size_t)NT * 512 + (size_t)r * 512 + c]);
    float mean = wave_sum(y) * (1.f / 64.f);
    float dv = y - mean;
    float var = wave_sum(dv * dv) * (1.f / 64.f);
    float yn = dv * rsqrtf(var + 64e-5f) * p.in[I_LNG][l * 512 + c] + p.in[I_LNB][l * 512 + c];
    float rr = ps_val(P, mu, r, q, c), kraw = ps_val(P, mu, r, q, 512 + c), vv = ps_val(P, mu, r, q, 1024 + c);
    float ka = p.in[I_KA][l * 512 + c];
    float a0 = bf2f(AA[((size_t)r * 2 + 0) * 512 + c]), a1 = bf2f(AA[((size_t)r * 2 + 1) * 512 + c]);
    float keffsum = kraw * (1.f + (a0 - 1.f) * ka) + kraw * (1.f + (a1 - 1.f) * ka);
    float bonus = wave_sum(rr * keffsum * p.in[I_RK][l * 512 + c]);
    float gg = bf2f(G[(size_t)r * 512 + c]);
    ((bf16_t*)(p.ws + WS_RW))[(size_t)r * 512 + c] = f2bf((yn + bonus * vv) * gg);
  }
}
DI void ph_mod2(const PT& p_, unsigned char* smem) {
  const PT p = launder(p_); const int TID = launder_v(threadIdx.x); const int BID = launder_s(blockIdx.x); (void)TID; (void)BID;
  float* cs = (float*)smem;
  float* red = cs + 5 * 1024;
  for (int i = TID; i < 5 * 1024; i += NTHR) { float v = i < 4096 ? p.in[I_C][i] : p.in[I_CCTX][i - 4096]; cs[i] = v / (1.f + __expf(-v)); }
  __syncthreads();
  float* MOD = (float*)(p.ws + WS_MOD);
  for (int chunk = BID; chunk < DEPTH * 6144 / 48; chunk += gridDim.x) {
    const int gc0 = chunk * 48, l = gc0 / 6144, n0 = gc0 % 6144;
    const float* W = p.in[I_ADAW] + (size_t)l * 1024 * 6144;
    const int c = TID % 48, kg = TID / 48;
    if (kg < 10) {
      float acc[5] = {0.f, 0.f, 0.f, 0.f, 0.f};
#pragma unroll 8
      for (int k = kg; k < 1024; k += 10) {
        const float w = W[(size_t)k * 6144 + n0 + c];
#pragma unroll
        for (int r = 0; r < 5; ++r) acc[r] += cs[r * 1024 + k] * w;
      }
#pragma unroll
      for (int r = 0; r < 5; ++r) red[(kg * 48 + c) * 5 + r] = acc[r];
    }
    __syncthreads();
    if (TID < 240) {
      const int cc = TID / 5, r = TID % 5;
      float a = p.in[I_ADAB][l * 6144 + n0 + cc];
      for (int kg2 = 0; kg2 < 10; ++kg2) a += red[(kg2 * 48 + cc) * 5 + r];
      MOD[(size_t)(l * 5 + r) * 6144 + n0 + cc] = a;
    }
    __syncthreads();
  }
}


constexpr int CS = 16, NCHK = (CTX + SEQ) / CS;
constexpr int S_VEC_SZ = 6 * CS * 64 * 4;
constexpr int S_BB = 2 * S_VEC_SZ;
constexpr int BB_PM = 0, BB_RM = 2048, BB_HP = 4096, BB_VM = 8192, BB_BK = 10240, BB_WC = 14336, BB_SZ = 14592;
constexpr int S_CB = S_BB + 3 * BB_SZ;
constexpr int CB_SZ = 2048;
constexpr int S_CSCR = S_CB + 2 * CB_SZ;
constexpr int SCAN2_LDS = S_CSCR + 2048;
static_assert(SCAN2_LDS <= 110 * 1024, "scan2 lds");

struct SRaw { unsigned pc[3], pv[3], nx[3], aa, dec; };
struct ChunkGeo { int rbase, t0, len, rdir; };
DI ChunkGeo chunk_geo(int b, int d, int chunk) {
  const int st0 = chunk * CS;
  const bool cx = st0 < CTX;
  const int s2 = cx ? st0 : st0 - CTX, L = cx ? CTX : SEQ;
  ChunkGeo q;
  q.t0 = d ? L - 1 - s2 : s2;
  q.rbase = (cx ? NLAT + b * CTX : b * SEQ) + q.t0;
  q.len = L; q.rdir = d ? -1 : 1;
  return q;
}
DI void sa_fetch(const bf16_t* P, const bf16_t* DEC, const bf16_t* AA, const ChunkGeo& q, int h, int d, int sl, int lane, SRaw& raw) {
  const int c0 = h * 64 + 2 * (lane & 31);
  const int r = q.rbase + q.rdir * sl, t = q.t0 + q.rdir * sl;
  const bf16_t* pr = P + (size_t)r * IN_COLS + MLA_COLS + c0;
  const int op = t > 0 ? -IN_COLS : 0, on = t < q.len - 1 ? IN_COLS : 0;
#pragma unroll
  for (int j = 0; j < 3; ++j) { raw.pc[j] = *(const unsigned*)(pr + j * 512); raw.pv[j] = *(const unsigned*)(pr + j * 512 + op); raw.nx[j] = *(const unsigned*)(pr + j * 512 + on); }
  raw.aa = *(const unsigned*)(AA + ((size_t)r * 2 + d) * 512 + c0);
  raw.dec = *(const unsigned*)(DEC + ((size_t)r * 2 + d) * 512 + c0);
}
DI void sa_emit(const SRaw& raw, const ScanConst& K, const ChunkGeo& q, int sl, int lane, float* vec) {
  const int half = lane >> 5, l2 = lane & 31;
  const int t = q.t0 + q.rdir * sl;
  const float mp = t > 0 ? 1.f : 0.f, mn = t < q.len - 1 ? 1.f : 0.f;
  float v[3][2];
#pragma unroll
  for (int j = 0; j < 3; ++j) {
    const float c0 = blo(raw.pc[j]), c1 = bhi(raw.pc[j]);
    v[j][0] = c0 + K.m0[j][0] * (mp * blo(raw.pv[j]) - c0) + K.m1[j][0] * (mn * blo(raw.nx[j]) - c0);
    v[j][1] = c1 + K.m0[j][1] * (mp * bhi(raw.pv[j]) - c1) + K.m1[j][1] * (mn * bhi(raw.nx[j]) - c1);
  }
  const float a0 = blo(raw.aa), a1 = bhi(raw.aa);
  const float w0 = __expf(-blo(raw.dec)), w1 = __expf(-bhi(raw.dec));
  float k0 = v[1][0] * K.kkw[0], k1 = v[1][1] * K.kkw[1];
  const float ss = sum16_dpp(k0 * k0 + k1 * k1);
  const float ssA = rdlane(ss, 0) + rdlane(ss, 16), ssB = rdlane(ss, 32) + rdlane(ss, 48);
  const float rn = rsqrtf((half ? ssB : ssA) + 1e-12f);
  k0 *= rn; k1 *= rn;
  float* o = vec + sl * 64 + 2 * l2;
  *(float2*)(o) = make_float2(k0, k1);
  *(float2*)(o + 1 * CS * 64) = make_float2(w0, w1);
  *(float2*)(o + 2 * CS * 64) = make_float2(k0 * a0, k1 * a1);
  *(float2*)(o + 3 * CS * 64) = make_float2(v[1][0] * (1.f + (a0 - 1.f) * K.kaw[0]), v[1][1] * (1.f + (a1 - 1.f) * K.kaw[1]));
  *(float2*)(o + 4 * CS * 64) = make_float2(v[0][0], v[0][1]);
  *(float2*)(o + 5 * CS * 64) = make_float2(v[2][0], v[2][1]);
}
DI void stage_b1(const float* vec, unsigned char* bb, int lane) {
  const int j = lane, jj = j & 31;
  const int slot = (((j >> 5) * 4 + ((jj & 15) >> 2)) * 8) + (jj & 3) + ((jj >> 4) << 2);
  bf16_t* PmP = (bf16_t*)(bb + BB_PM); bf16_t* RmP = (bf16_t*)(bb + BB_RM);
  float Wc = 1.f;
  float ikk[16], iw[16], ir[16];
#pragma unroll
  for (int s = 0; s < 16; ++s) { ikk[s] = vec[(0 * CS + s) * 64 + j]; iw[s] = vec[(1 * CS + s) * 64 + j]; ir[s] = vec[(4 * CS + s) * 64 + j]; }
#pragma unroll
  for (int s = 0; s < 16; ++s) {
    const float pm = Wc * ikk[s];
    Wc *= iw[s];
    const float rm = Wc * ir[s];
    PmP[s * 64 + slot] = f2bf(pm); RmP[s * 64 + slot] = f2bf(rm);
  }
}
DI void stage_b2(const float* vec, unsigned char* bb, int lane) {
  const int j = lane, jj = j & 31;
  const int slot = (((j >> 5) * 4 + ((jj & 15) >> 2)) * 8) + (jj & 3) + ((jj >> 4) << 2);
  bf16_t* HP = (bf16_t*)(bb + BB_HP);
  bf16_t* VmP = (bf16_t*)(bb + BB_VM); bf16_t* BKP = (bf16_t*)(bb + BB_BK); float* WcC = (float*)(bb + BB_WC);
  float Wc = 1.f; float bt[16], kt[16];
  float iw[16], ib[16], ik[16], iv[16];
#pragma unroll
  for (int s = 0; s < 16; ++s) { iw[s] = vec[(1 * CS + s) * 64 + j]; ib[s] = vec[(2 * CS + s) * 64 + j]; ik[s] = vec[(3 * CS + s) * 64 + j]; iv[s] = vec[(5 * CS + s) * 64 + j]; }
#pragma unroll
  for (int s = 0; s < 16; ++s) {
    Wc *= iw[s];
    const float inv = __builtin_amdgcn_rcpf(Wc);
    bt[s] = ib[s] * inv; kt[s] = ik[s] * inv;
    BKP[s * 64 + slot] = f2bf(bt[s]); BKP[(16 + s) * 64 + slot] = f2bf(kt[s]);
  }
  WcC[j] = Wc;
#pragma unroll
  for (int g = 0; g < 4; ++g) {
    uint4 o;
    o.x = pack2(-bt[4 * g] * Wc, -bt[4 * g + 1] * Wc); o.y = pack2(-bt[4 * g + 2] * Wc, -bt[4 * g + 3] * Wc);
    o.z = pack2(kt[4 * g] * Wc, kt[4 * g + 1] * Wc);   o.w = pack2(kt[4 * g + 2] * Wc, kt[4 * g + 3] * Wc);
    *(uint4*)(HP + j * 32 + g * 8) = o;
    uint2 vq;
    vq.x = pack2(iv[4 * g], iv[4 * g + 1]); vq.y = pack2(iv[4 * g + 2], iv[4 * g + 3]);
    *(uint2*)(VmP + (((j >> 4) * 4 + g) * 16 + (j & 15)) * 4) = vq;
  }
}
DI void stage_c(const unsigned char* bb, unsigned char* cb, float* scr, int lane) {
  (void)scr;
  const int l15 = lane & 15, g = lane >> 4;
  const bf16_t* PmP = (const bf16_t*)(bb + BB_PM); const bf16_t* RmP = (const bf16_t*)(bb + BB_RM); const bf16_t* BKP = (const bf16_t*)(bb + BB_BK);
  bf16_t* G1P = (bf16_t*)cb; bf16_t* G2P = G1P + 16 * 32;
  const f32x4 z4 = {0.f, 0.f, 0.f, 0.f};
  f32x4 oPB = z4, oPK = z4, oRB = z4, oRK = z4, oBP = z4;
#pragma unroll
  for (int ks = 0; ks < 2; ++ks) {
    const bf16x8 aP = *(const bf16x8*)(PmP + l15 * 64 + (ks * 4 + g) * 8), aR = *(const bf16x8*)(RmP + l15 * 64 + (ks * 4 + g) * 8);
    const bf16x8 bB = *(const bf16x8*)(BKP + l15 * 64 + (ks * 4 + g) * 8), bK = *(const bf16x8*)(BKP + (16 + l15) * 64 + (ks * 4 + g) * 8);
    oPB = __builtin_amdgcn_mfma_f32_16x16x32_bf16(aP, bB, oPB, 0, 0, 0); oBP = __builtin_amdgcn_mfma_f32_16x16x32_bf16(bB, aP, oBP, 0, 0, 0);
    oPK = __builtin_amdgcn_mfma_f32_16x16x32_bf16(aP, bK, oPK, 0, 0, 0);
    oRB = __builtin_amdgcn_mfma_f32_16x16x32_bf16(aR, bB, oRB, 0, 0, 0); oRK = __builtin_amdgcn_mfma_f32_16x16x32_bf16(aR, bK, oRK, 0, 0, 0);
  }
  f32x4 nC, nT, XT, XB;
#pragma unroll
  for (int r = 0; r < 4; ++r) {
    const int sI = 4 * g + r;
    nC[r] = l15 < sI ? -oPB[r] : 0.f;
    nT[r] = sI < l15 ? -oBP[r] : 0.f;
    XT[r] = ((sI == l15) ? 1.f : 0.f) + nC[r];
    XB[r] = l15 < sI ? oPK[r] : 0.f;
    G2P[sI * 32 + (l15 >> 2) * 8 + (l15 & 3)] = f2bf(l15 <= sI ? -oRB[r] : 0.f);
    G2P[sI * 32 + (l15 >> 2) * 8 + 4 + (l15 & 3)] = f2bf(l15 <= sI ? oRK[r] : 0.f);
  }
#define PK4(v) __builtin_bit_cast(bf16x8, make_uint4(pack2((v)[0], (v)[1]), pack2((v)[2], (v)[3]), 0u, 0u))
  const bf16x8 a1 = PK4(nT), a1t = PK4(nC);
  XB = __builtin_amdgcn_mfma_f32_16x16x32_bf16(a1, PK4(XB), XB, 0, 0, 0);
  const f32x4 p2 = __builtin_amdgcn_mfma_f32_16x16x32_bf16(a1, a1t, z4, 0, 0, 0), q2 = __builtin_amdgcn_mfma_f32_16x16x32_bf16(a1t, a1, z4, 0, 0, 0);
  const bf16x8 a2 = PK4(q2), a2t = PK4(p2);
  XT = __builtin_amdgcn_mfma_f32_16x16x32_bf16(a2, PK4(XT), XT, 0, 0, 0);
  XB = __builtin_amdgcn_mfma_f32_16x16x32_bf16(a2, PK4(XB), XB, 0, 0, 0);
  const f32x4 p4 = __builtin_amdgcn_mfma_f32_16x16x32_bf16(a2, a2t, z4, 0, 0, 0), q4 = __builtin_amdgcn_mfma_f32_16x16x32_bf16(a2t, a2, z4, 0, 0, 0);
  const bf16x8 a4 = PK4(q4), a4t = PK4(p4);
  XT = __builtin_amdgcn_mfma_f32_16x16x32_bf16(a4, PK4(XT), XT, 0, 0, 0);
  XB = __builtin_amdgcn_mfma_f32_16x16x32_bf16(a4, PK4(XB), XB, 0, 0, 0);
  const f32x4 q8 = __builtin_amdgcn_mfma_f32_16x16x32_bf16(a4t, a4, z4, 0, 0, 0);
  const bf16x8 a8 = PK4(q8);
  XT = __builtin_amdgcn_mfma_f32_16x16x32_bf16(a8, PK4(XT), XT, 0, 0, 0);
  XB = __builtin_amdgcn_mfma_f32_16x16x32_bf16(a8, PK4(XB), XB, 0, 0, 0);
#undef PK4
#pragma unroll
  for (int r = 0; r < 4; ++r) {
    const int u = 4 * g + r;
    G1P[u * 32 + (l15 >> 2) * 8 + (l15 & 3)] = f2bf(XT[r]);
    G1P[u * 32 + (l15 >> 2) * 8 + 4 + (l15 & 3)] = f2bf(XB[r]);
  }
}
DI void scan_consume(f32x4 (&st)[4], const unsigned char* smem, bf16_t* YS, int i, int b, int d, int w, int l15, int g) {
  const unsigned char* bb = smem + S_BB + (i % 3) * BB_SZ;
  const unsigned char* cbuf = smem + S_CB + (i & 1) * CB_SZ;
  const bf16_t* PmP = (const bf16_t*)(bb + BB_PM); const bf16_t* RmP = (const bf16_t*)(bb + BB_RM); const bf16_t* HP = (const bf16_t*)(bb + BB_HP);
  const bf16_t* VmP = (const bf16_t*)(bb + BB_VM); const float* WcC = (const float*)(bb + BB_WC);
  const bf16_t* G1P = (const bf16_t*)cbuf; const bf16_t* G2P = G1P + 16 * 32;
  f32x4 d1 = {0.f, 0.f, 0.f, 0.f}, d2 = d1;
#pragma unroll
  for (int ks = 0; ks < 2; ++ks) {
    uint4 sp;
    sp.x = pack2(st[2 * ks][0], st[2 * ks][1]); sp.y = pack2(st[2 * ks][2], st[2 * ks][3]);
    sp.z = pack2(st[2 * ks + 1][0], st[2 * ks + 1][1]); sp.w = pack2(st[2 * ks + 1][2], st[2 * ks + 1][3]);
    const bf16x8 sf = __builtin_bit_cast(bf16x8, sp);
    const bf16x8 aP = *(const bf16x8*)(PmP + l15 * 64 + (ks * 4 + g) * 8), aR = *(const bf16x8*)(RmP + l15 * 64 + (ks * 4 + g) * 8);
    d1 = __builtin_amdgcn_mfma_f32_16x16x32_bf16(aP, sf, d1, 0, 0, 0);
    d2 = __builtin_amdgcn_mfma_f32_16x16x32_bf16(aR, sf, d2, 0, 0, 0);
  }
  const uint2 vm = *(const uint2*)(VmP + ((w * 4 + g) * 16 + l15) * 4);
  uint4 ep; ep.x = pack2(d1[0], d1[1]); ep.y = pack2(d1[2], d1[3]); ep.z = vm.x; ep.w = vm.y;
  const bf16x8 g1 = *(const bf16x8*)(G1P + l15 * 32 + g * 8);
  const f32x4 zero4 = {0.f, 0.f, 0.f, 0.f};
  const f32x4 skt = __builtin_amdgcn_mfma_f32_16x16x32_bf16(g1, __builtin_bit_cast(bf16x8, ep), zero4, 0, 0, 0);
  uint4 fp; fp.x = pack2(skt[0], skt[1]); fp.y = pack2(skt[2], skt[3]); fp.z = vm.x; fp.w = vm.y;
  const bf16x8 ff = __builtin_bit_cast(bf16x8, fp);
  const bf16x8 g2 = *(const bf16x8*)(G2P + l15 * 32 + g * 8);
  const f32x4 yt = __builtin_amdgcn_mfma_f32_16x16x32_bf16(g2, ff, d2, 0, 0, 0);
#pragma unroll
  for (int r = 0; r < 4; ++r) YS[(size_t)scan_row(b, d, i * CS + 4 * g + r) * 512] = f2bf(yt[r]);
#pragma unroll
  for (int jt = 0; jt < 4; ++jt) {
    const float4 wc = *(const float4*)(WcC + 16 * jt + 4 * g);
    f32x4 sc = st[jt];
    sc[0] *= wc.x; sc[1] *= wc.y; sc[2] *= wc.z; sc[3] *= wc.w;
    const bf16x8 hf = *(const bf16x8*)(HP + (jt * 16 + l15) * 32 + g * 8);
    st[jt] = __builtin_amdgcn_mfma_f32_16x16x32_bf16(hf, ff, sc, 0, 0, 0);
  }
}
DI void ph_scan2(const PT& p, int l, unsigned char* smem, const int TID, const int job, const int xmode) {
  const int lane = TID & 63, w = TID >> 6, l15 = lane & 15, g = lane >> 4;
  const int d = job & 1, h = (job >> 1) & 7, b = job >> 4;
  float* vecb = (float*)smem;
  const bf16_t* P = (const bf16_t*)(p.ws + WS_P);
  const bf16_t* DEC = (const bf16_t*)(p.ws + WS_DEC);
  const bf16_t* AA = (const bf16_t*)(p.ws + WS_AA);
  const int half = lane >> 5;
#define SA_CONST() ScanConst K; { const int c0 = h * 64 + 2 * (lane & 31); const float* mu = p.in[I_MU] + (size_t)l * 2 * RW_COLS; \
      _Pragma("unroll") for (int j = 0; j < 3; ++j) _Pragma("unroll") for (int e = 0; e < 2; ++e) { K.m0[j][e] = mu[j * 512 + c0 + e]; K.m1[j][e] = mu[RW_COLS + j * 512 + c0 + e]; } \
      _Pragma("unroll") for (int e = 0; e < 2; ++e) { K.kkw[e] = p.in[I_KK][l * 512 + c0 + e]; K.kaw[e] = p.in[I_KA][l * 512 + c0 + e]; } }
#define SA_FETCH(SET, NU, SB, chunk) do { const ChunkGeo cg_ = chunk_geo(b, d, (xmode & 2) ? 5 : min((chunk), NCHK - 1)); _Pragma("unroll") for (int u = 0; u < NU; ++u) sa_fetch(P, DEC, AA, cg_, h, d, (SB) + 2 * u + half, lane, SET[u]); } while (0)
#define SA_EMIT(SET, NU, SB, chunk) do { float* vec_ = vecb + ((chunk) & 1) * (S_VEC_SZ / 4); const ChunkGeo cg_ = chunk_geo(b, d, min((chunk), NCHK - 1));   \
      _Pragma("unroll") for (int u = 0; u < NU; ++u) sa_emit(SET[u], K, cg_, (SB) + 2 * u + half, lane, vec_); } while (0)
  if (w < 4) {
    bf16_t* YS = (bf16_t*)(p.ws + WS_BUFA) + (size_t)d * NT * 512 + h * 64 + w * 16 + l15;
    SA_CONST();
    const int sbase = 2 * w;
    SRaw r0[1];
    SA_FETCH(r0, 1, sbase, 0);
    f32x4 st[4];
#pragma unroll
    for (int jt = 0; jt < 4; ++jt) st[jt] = (f32x4){0.f, 0.f, 0.f, 0.f};
    auto cons_step = [&](const int i, const bool store) {
        const unsigned char* bb = smem + S_BB + (i % 3) * BB_SZ;
        const unsigned char* cbuf = smem + S_CB + (i & 1) * CB_SZ;
        const bf16_t* PmP = (const bf16_t*)(bb + BB_PM); const bf16_t* RmP = (const bf16_t*)(bb + BB_RM); const bf16_t* HP = (const bf16_t*)(bb + BB_HP);
        const bf16_t* VmP = (const bf16_t*)(bb + BB_VM); const float* WcC = (const float*)(bb + BB_WC);
        const bf16_t* G1P = (const bf16_t*)cbuf; const bf16_t* G2P = G1P + 16 * 32;
        const bf16x8 aP0 = *(const bf16x8*)(PmP + l15 * 64 + g * 8), aR0 = *(const bf16x8*)(RmP + l15 * 64 + g * 8);
        const bf16x8 aP1 = *(const bf16x8*)(PmP + l15 * 64 + (4 + g) * 8), aR1 = *(const bf16x8*)(RmP + l15 * 64 + (4 + g) * 8);
        const uint2 vm = *(const uint2*)(VmP + ((w * 4 + g) * 16 + l15) * 4);
        const bf16x8 g1 = *(const bf16x8*)(G1P + l15 * 32 + g * 8);
        const bf16x8 g2 = *(const bf16x8*)(G2P + l15 * 32 + g * 8);
        float4 wc[4]; bf16x8 hf[4];
#pragma unroll
        for (int jt = 0; jt < 4; ++jt) { wc[jt] = *(const float4*)(WcC + 16 * jt + 4 * g); hf[jt] = *(const bf16x8*)(HP + (jt * 16 + l15) * 32 + g * 8); }
        __builtin_amdgcn_sched_barrier(0);
        f32x4 d1 = {0.f, 0.f, 0.f, 0.f}, d2 = d1;
        {
          uint4 sp;
          sp.x = pack2(st[0][0], st[0][1]); sp.y = pack2(st[0][2], st[0][3]); sp.z = pack2(st[1][0], st[1][1]); sp.w = pack2(st[1][2], st[1][3]);
          const bf16x8 sf = __builtin_bit_cast(bf16x8, sp);
          d1 = __builtin_amdgcn_mfma_f32_16x16x32_bf16(aP0, sf, d1, 0, 0, 0);
          d2 = __builtin_amdgcn_mfma_f32_16x16x32_bf16(aR0, sf, d2, 0, 0, 0);
          sp.x = pack2(st[2][0], st[2][1]); sp.y = pack2(st[2][2], st[2][3]); sp.z = pack2(st[3][0], st[3][1]); sp.w = pack2(st[3][2], st[3][3]);
          const bf16x8 sg = __builtin_bit_cast(bf16x8, sp);
          d1 = __builtin_amdgcn_mfma_f32_16x16x32_bf16(aP1, sg, d1, 0, 0, 0);
          d2 = __builtin_amdgcn_mfma_f32_16x16x32_bf16(aR1, sg, d2, 0, 0, 0);
        }
        uint4 ep; ep.x = pack2(d1[0], d1[1]); ep.y = pack2(d1[2], d1[3]); ep.z = vm.x; ep.w = vm.y;
        const f32x4 zero4 = {0.f, 0.f, 0.f, 0.f};
        const f32x4 skt = __builtin_amdgcn_mfma_f32_16x16x32_bf16(g1, __builtin_bit_cast(bf16x8, ep), zero4, 0, 0, 0);
        uint4 fp; fp.x = pack2(skt[0], skt[1]); fp.y = pack2(skt[2], skt[3]); fp.z = vm.x; fp.w = vm.y;
        const bf16x8 ff = __builtin_bit_cast(bf16x8, fp);
        const f32x4 yt = __builtin_amdgcn_mfma_f32_16x16x32_bf16(g2, ff, d2, 0, 0, 0);
#pragma unroll
        for (int jt = 0; jt < 4; ++jt) {
          f32x4 sc = st[jt];
          sc[0] *= wc[jt].x; sc[1] *= wc[jt].y; sc[2] *= wc[jt].z; sc[3] *= wc[jt].w;
          st[jt] = __builtin_amdgcn_mfma_f32_16x16x32_bf16(hf[jt], ff, sc, 0, 0, 0);
        }
        if (store) {
          const ChunkGeo q = chunk_geo(b, d, i);
          bf16_t* yp = YS + (ptrdiff_t)(q.rbase + q.rdir * 4 * g) * 512;
          const ptrdiff_t ystep = (ptrdiff_t)q.rdir * 512;
#pragma unroll
          for (int r = 0; r < 4; ++r) yp[r * ystep] = f2bf(yt[r]);
        }
    };
#pragma nounroll
    for (int c = 0; c < 3; ++c) { SA_EMIT(r0, 1, sbase, c); SA_FETCH(r0, 1, sbase, c + 1); __syncthreads(); }
#pragma nounroll
    for (int i = 0; i < NCHK; ++i) {
      cons_step(i, !(xmode & 1));
      SA_EMIT(r0, 1, sbase, i + 3); SA_FETCH(r0, 1, sbase, i + 4);
      __syncthreads();
    }
#if SCX >= 0
    for (int it = 0; it < NCHK; ++it) {
      const int cdm_ = launder_s(NCHK - 1);
      if (SCX == 5 || SCX == 7) cons_step(cdm_, false);
      if (SCX == 5 || SCX == 6 || SCX == 7) { SA_EMIT(r0, 1, sbase, cdm_); SA_FETCH(r0, 1, sbase, cdm_); }
      __syncthreads();
    }
#endif
  } else if (w == 4) {
    SA_CONST();
    SRaw r0[2];
    SA_FETCH(r0, 2, 8, 0);
#pragma nounroll
    for (int ce = 0; ce < NCHK + 3; ++ce) {
      SA_EMIT(r0, 2, 8, ce); SA_FETCH(r0, 2, 8, ce + 1);
      __syncthreads();
    }
#if SCX >= 0
    for (int it = 0; it < NCHK; ++it) {
      const int cdm_ = launder_s(NCHK - 1);
      if (SCX == 1 || SCX == 6 || SCX == 7) { SA_EMIT(r0, 2, 8, cdm_); SA_FETCH(r0, 2, 8, cdm_); }
      __syncthreads();
    }
#endif
  } else if (w == 6) {
    for (int i = -3; i < NCHK; ++i) {
      const int cbk = i + 2;
      if (cbk >= 0 && cbk < NCHK) stage_b2(vecb + (cbk & 1) * (S_VEC_SZ / 4), smem + S_BB + (cbk % 3) * BB_SZ, lane);
      __syncthreads();
    }
#if SCX >= 0
    for (int it = 0; it < NCHK; ++it) {
      const int cdm_ = launder_s(NCHK - 1);
      if (SCX == 3 || SCX == 7) stage_b2(vecb + (cdm_ & 1) * (S_VEC_SZ / 4), smem + S_BB + (cdm_ % 3) * BB_SZ, lane);
      __syncthreads();
    }
#endif
  } else {
    SA_CONST();
    const int sbase = w == 5 ? 12 : 14;
    SRaw r0[1];
    SA_FETCH(r0, 1, sbase, 0);
#define SB_RUN(ce_) do { if (w == 5) { const int cbk_ = (ce_) - 1; stage_b1(vecb + (cbk_ & 1) * (S_VEC_SZ / 4), smem + S_BB + (cbk_ % 3) * BB_SZ, lane); } \
                         else { const int cc_ = (ce_) - 2; stage_c(smem + S_BB + (cc_ % 3) * BB_SZ, smem + S_CB + (cc_ & 1) * CB_SZ, (float*)(smem + S_CSCR), lane); } } while (0)
    SA_EMIT(r0, 1, sbase, 0); SA_FETCH(r0, 1, sbase, 1); __syncthreads();
    if (w == 5) SB_RUN(1);
    SA_EMIT(r0, 1, sbase, 1); SA_FETCH(r0, 1, sbase, 2); __syncthreads();
#pragma nounroll
    for (int ce = 2; ce < NCHK + 3; ++ce) {
      SB_RUN(ce);
      SA_EMIT(r0, 1, sbase, ce); SA_FETCH(r0, 1, sbase, ce + 1);
      __syncthreads();
    }
#if SCX >= 0
    for (int it = 0; it < NCHK; ++it) {
      const int cdm_ = launder_s(NCHK - 1);
      if (SCX == (w == 5 ? 2 : 4) || SCX == 7) SB_RUN(cdm_ + (w == 5 ? 1 : 2));
      if (SCX == (w == 5 ? 2 : 4) || SCX == 6 || SCX == 7) { SA_EMIT(r0, 1, sbase, cdm_); SA_FETCH(r0, 1, sbase, cdm_); }
      __syncthreads();
    }
#endif
#undef SB_RUN
  }
#undef SA_FETCH
#undef SA_EMIT
#undef SA_CONST
}
constexpr int ATT2_BUF = (12 + 8) * 64 * 8;
DI void attn_item2(const PT& p, unsigned char* smem, const int TID, int b, int h, int qrow0, int key0, int nkt) {
  bf16_t* base = (bf16_t*)smem;
  const int lane = TID & 63, w = TID >> 6, l15 = lane & 15, g = lane >> 4;
  bf16_t* Qg = (bf16_t*)(p.ws + WS_Q);
  const bf16_t* KN = (const bf16_t*)(p.ws + WS_KN);
  const bf16_t* KR = (const bf16_t*)(p.ws + WS_KR);
  const bf16_t* VT = (const bf16_t*)(p.ws + WS_VT) + (size_t)(b * 8 + h) * 64 * KEYS;
  bf16x8 qf[2][3];
#pragma unroll
  for (int qt = 0; qt < 2; ++qt)
#pragma unroll
    for (int ks = 0; ks < 3; ++ks) qf[qt][ks] = *(const bf16x8*)(Qg + (size_t)(qrow0 + w * 32 + qt * 16 + l15) * 768 + h * 96 + ks * 32 + g * 8);
  f32x4 oacc[4][2];
#pragma unroll
  for (int i = 0; i < 4; ++i)
#pragma unroll
    for (int j = 0; j < 2; ++j) oacc[i][j] = (f32x4){0.f, 0.f, 0.f, 0.f};
  float mrun[2] = {-1e30f, -1e30f}, lsum[2] = {0.f, 0.f};
  const int skey = TID & 63, sc8 = TID >> 6;
  const int lrow = (skey & ~31) | (((skey >> 2) & 1) << 4) | (((skey >> 3) & 3) << 2) | (skey & 3);
  const int rc = (TID >> 6) & 3;
  uint4 r_kn, r_kr, r_vt;
  r_kr = make_uint4(0u, 0u, 0u, 0u);
#define AT_LOAD(tile_) do { const int k0_ = key0 + (tile_) * 64; const size_t kr0_ = (size_t)b * KEYS + k0_; \
    r_kn = *(const uint4*)(KN + ((kr0_ + skey) * 8 + h) * 64 + sc8 * 8); \
    if (TID < 256) r_kr = *(const uint4*)(KR + (kr0_ + skey) * 32 + rc * 8); \
    r_vt = *(const uint4*)(VT + (size_t)skey * KEYS + k0_ + sc8 * 8); } while (0)
#define AT_WRITE(bi_) do { bf16_t* Ks_ = base + (bi_) * ATT2_BUF; bf16_t* Vs_ = Ks_ + 12 * 64 * 8; \
    *(uint4*)(Ks_ + (sc8 * 64 + lrow) * 8) = r_kn; \
    if (TID < 256) *(uint4*)(Ks_ + ((8 + rc) * 64 + lrow) * 8) = r_kr; \
    *(uint4*)(Vs_ + (sc8 * 64 + skey) * 8) = r_vt; } while (0)
  AT_LOAD(0); AT_WRITE(0);
  AT_LOAD(1); AT_WRITE(1);
  __syncthreads();
  f32x4 sacc[4][2];
  const auto qk = [&](const int bi) {
    const bf16_t* Ks = base + bi * ATT2_BUF;
#pragma unroll
    for (int i = 0; i < 4; ++i)
#pragma unroll
      for (int j = 0; j < 2; ++j) sacc[i][j] = (f32x4){0.f, 0.f, 0.f, 0.f};
#pragma unroll
    for (int ks = 0; ks < 3; ++ks) {
#pragma unroll
      for (int kt = 0; kt < 4; ++kt) {
        const bf16x8 kf = *(const bf16x8*)(Ks + ((ks * 4 + g) * 64 + kt * 16 + l15) * 8);
#pragma unroll
        for (int qt = 0; qt < 2; ++qt) sacc[kt][qt] = __builtin_amdgcn_mfma_f32_16x16x32_bf16(kf, qf[qt][ks], sacc[kt][qt], 0, 0, 0);
      }
    }
  };
  const auto smpv = [&](const int bi) {
    const bf16_t* Vs = base + bi * ATT2_BUF + 12 * 64 * 8;
#pragma unroll
    for (int qt = 0; qt < 2; ++qt) {
      float mx = sacc[0][qt][0];
#pragma unroll
      for (int kt = 0; kt < 4; ++kt)
#pragma unroll
        for (int r = 0; r < 4; ++r) mx = fmaxf(mx, sacc[kt][qt][r]);
      mx = fmaxf(mx, __shfl_xor(mx, 16));
      mx = fmaxf(mx, __shfl_xor(mx, 32));
      const float mn = fmaxf(mrun[qt], mx * LOG2E);
      float ls = lsum[qt];
      if (__any(mn > mrun[qt])) {
        const float alpha = __builtin_amdgcn_exp2f(mrun[qt] - mn);
        ls *= alpha;
#pragma unroll
        for (int vt = 0; vt < 4; ++vt) oacc[vt][qt] *= alpha;
      }
      mrun[qt] = mn;
#pragma unroll
      for (int kt = 0; kt < 4; ++kt)
#pragma unroll
        for (int r = 0; r < 4; ++r) { float pv = __builtin_amdgcn_exp2f(sacc[kt][qt][r] * LOG2E - mn); ls += pv; sacc[kt][qt][r] = pv; }
      lsum[qt] = ls;
    }
#pragma unroll
    for (int s2 = 0; s2 < 2; ++s2) {
      bf16x8 pf[2];
#pragma unroll
      for (int qt = 0; qt < 2; ++qt) {
        uint4 pk;
        pk.x = pack2(sacc[2 * s2][qt][0], sacc[2 * s2][qt][1]); pk.y = pack2(sacc[2 * s2][qt][2], sacc[2 * s2][qt][3]);
        pk.z = pack2(sacc[2 * s2 + 1][qt][0], sacc[2 * s2 + 1][qt][1]); pk.w = pack2(sacc[2 * s2 + 1][qt][2], sacc[2 * s2 + 1][qt][3]);
        pf[qt] = __builtin_bit_cast(bf16x8, pk);
      }
#pragma unroll
      for (int vt = 0; vt < 4; ++vt) {
        const bf16x8 vf = *(const bf16x8*)(Vs + ((s2 * 4 + g) * 64 + vt * 16 + l15) * 8);
#pragma unroll
        for (int qt = 0; qt < 2; ++qt) oacc[vt][qt] = __builtin_amdgcn_mfma_f32_16x16x32_bf16(vf, pf[qt], oacc[vt][qt], 0, 0, 0);
      }
    }
  };
  int bc = 0, bn = 1, bw = 2;
  if (w < 4) {
    for (int t = 0; t < nkt; ++t) {
      const bool more = (t + 2 < nkt);
      if (more) AT_LOAD(t + 2);
      qk(bc);
      smpv(bc);
      if (more) AT_WRITE(bw);
      __syncthreads();
      const int tmp = bc; bc = bn; bn = bw; bw = tmp;
    }
  } else {
    qk(0);
    for (int t = 0; t < nkt; ++t) {
      const bool more = (t + 2 < nkt);
      if (more) AT_LOAD(t + 2);
      smpv(bc);
      if (more) AT_WRITE(bw);
      if (t + 1 < nkt) qk(bn);
      __syncthreads();
      const int tmp = bc; bc = bn; bn = bw; bw = tmp;
    }
  }
#undef AT_LOAD
#undef AT_WRITE
#pragma unroll
  for (int qt = 0; qt < 2; ++qt) {
    float lq = lsum[qt];
    lq += __shfl_xor(lq, 16); lq += __shfl_xor(lq, 32);
    const float inv = 1.f / lq;
    bf16_t* orow = Qg + (size_t)(qrow0 + w * 32 + qt * 16 + l15) * 768 + h * 96;
#pragma unroll
    for (int vt = 0; vt < 4; ++vt) {
      uint2 o2; o2.x = pack2(oacc[vt][qt][0] * inv, oacc[vt][qt][1] * inv); o2.y = pack2(oacc[vt][qt][2] * inv, oacc[vt][qt][3] * inv);
      *(uint2*)(orow + vt * 16 + 4 * g) = o2;
    }
  }
}
__shared__ int s_item;
DI void ph_p4_scan(const PT& p_, int l, unsigned char* smem) {
  const PT p = launder(p_); const int TID = launder_v(threadIdx.x); const int BID = launder_s(blockIdx.x); (void)TID; (void)BID;
  if (BID < 64) { ph_scan2(p, l, smem, TID, BID, launder_s(0)); if (SCX == -2) { __syncthreads(); ph_scan2(p, l, smem, launder_v(TID), launder_s(BID), launder_s(XM)); } }
}
DI void ph_p4_queue(const PT& p_, int l, unsigned char* smem) {
  const PT p = launder(p_); const int TID = launder_v(threadIdx.x); const int BID = launder_s(blockIdx.x); (void)TID; (void)BID;
  int* QC = (int*)(p.ws + WS_CTL) + 64 + l;
  const int TM = rows_after_mixer(l) / BM, N_ATT = 512 + ((l + 1 < DEPTH) ? 32 : 0), N_GATE = TM * 4;
  const float* mu = p.in[I_MU] + (size_t)l * 2 * RW_COLS;
  for (;;) {
    __syncthreads();
    if (TID == 0) s_item = atomicAdd(QC, 1);
    __syncthreads();
    const int item = s_item;
    if (item >= N_ATT + N_GATE) break;
    if (item < N_ATT) {
      const bool lat = item < 512;
      const int bh = lat ? (item & 31) : (item - 512), qb = item >> 5;
      const int b = bh >> 3, h = bh & 7;
      attn_item2(p, smem, TID, b, h, lat ? b * SEQ + qb * 256 : NLAT + b * CTX, lat ? 0 : SEQ, lat ? KEYS / 64 : CTX / 64);
    } else {
      int mt, nt; band_tile(item - N_ATT, TM, 4, 8, mt, nt);
      const OpGate op{(const bf16_t*)(p.ws + WS_P), mu, p.in[I_G2] + (size_t)l * 160 * 512, (bf16_t*)(p.ws + WS_P), mt * BM, nt * BN};
      gemm_tile(op, smem, TID);
    }
  }
}
#define XB_TMO      128
#define XB_XCNT(j)  (256  + 64 * (j))
#define XB_XSUB(j)  (1280 + 64 * (j))
#define XB_XGEN(j)  (2304 + 64 * (j))
#define XB_TOP      3328
#define XB_TOPGEN   3392
#define XCD_BAR_WORDS 3456
#define XB_SPIN_CAP (1u << 22)
#define LAS __attribute__((address_space(3)))
DI unsigned xb_ld(unsigned* p)              { return __hip_atomic_load(p, __ATOMIC_RELAXED, __HIP_MEMORY_SCOPE_AGENT); }
DI unsigned xb_add(unsigned* p, unsigned v) { return __hip_atomic_fetch_add(p, v, __ATOMIC_RELAXED, __HIP_MEMORY_SCOPE_AGENT); }
DI unsigned xb_xcc_id() { return (unsigned)__builtin_amdgcn_s_getreg((3 << 11) | 20) & 0xFu; }
#define XB_SPIN(cond, bar) do { unsigned _sp = 0; while (cond) { __builtin_amdgcn_s_sleep(1); \
    if ((++_sp & 255u) == 0u) { if (xb_ld(&(bar)[XB_TMO])) break; if (_sp > XB_SPIN_CAP) { atomicAdd(&(bar)[XB_TMO], 1u); break; } } } } while (0)
struct XcdBarrier { unsigned* bar; unsigned x; volatile LAS unsigned* st; };
DI XcdBarrier xcd_barrier_post(unsigned* bar, volatile LAS unsigned* st) {
  XcdBarrier b; b.bar = bar; b.x = xb_xcc_id(); b.st = st;
  if (threadIdx.x == 0) (void)xb_add(&bar[XB_XCNT(b.x)], 1u);
  return b;
}
DI void xcd_barrier_complete(unsigned* bar, unsigned x, unsigned& nloc, unsigned& nx) {
  const unsigned G = gridDim.x * gridDim.y * gridDim.z;
  unsigned sum, cnt, mine, sp = 0u;
  for (;;) {
    sum = 0u; cnt = 0u; mine = 0u;
#pragma unroll
    for (unsigned j = 0; j < 16; ++j) { const unsigned c = xb_ld(&bar[XB_XCNT(j)]); sum += c; cnt += (c > 0u) ? 1u : 0u; mine = (j == x) ? c : mine; }
    if (sum == G) break;
    __builtin_amdgcn_s_sleep(1);
    if ((++sp & 255u) == 0u) { if (xb_ld(&bar[XB_TMO])) break; if (sp > XB_SPIN_CAP) { atomicAdd(&bar[XB_TMO], 1u); break; } }
  }
  nloc = mine > 0u ? mine : 1u; nx = cnt > 0u ? cnt : 1u;
}
DI void xcd_barrier(const XcdBarrier& b) {
  asm volatile("s_waitcnt vmcnt(0)" ::: "memory");
  __syncthreads();
  if (threadIdx.x == 0) {
    unsigned* bar = b.bar;
    __builtin_amdgcn_s_waitcnt(0);
    unsigned nloc = b.st[0], nx = b.st[1];
    if (nloc == 0u) { xcd_barrier_complete(bar, b.x, nloc, nx); b.st[0] = nloc; b.st[1] = nx; }
    const unsigned old = xb_add(&bar[XB_XSUB(b.x)], 1u);
    const unsigned gen = old / nloc;
    if (old + 1u == (gen + 1u) * nloc) {
      __builtin_amdgcn_fence(__ATOMIC_RELEASE, "agent");
      asm volatile("s_waitcnt vmcnt(0)" ::: "memory");
      const unsigned og = xb_add(&bar[XB_TOP], 1u);
      const unsigned tg = og / nx;
      if (og + 1u == (tg + 1u) * nx) xb_add(&bar[XB_TOPGEN], 1u);
      else XB_SPIN(xb_ld(&bar[XB_TOPGEN]) == tg, bar);
      __builtin_amdgcn_fence(__ATOMIC_ACQUIRE, "agent");
      xb_add(&bar[XB_XGEN(b.x)], 1u);
      asm volatile("s_waitcnt vmcnt(0)" ::: "memory");
    } else {
      XB_SPIN(xb_ld(&bar[XB_XGEN(b.x)]) == gen, bar);
      __builtin_amdgcn_fence(__ATOMIC_ACQUIRE, "agent");
      asm volatile("s_waitcnt vmcnt(0)" ::: "memory");
    }
  }
  __syncthreads();
}
constexpr size_t WS_BAR = WS_CTL + 4096;
constexpr size_t WS_TS  = WS_CTL + 32768;
#ifndef USE_CG_SYNC
#define USE_CG_SYNC 0
#endif
#ifndef DBL_PHASE
#define DBL_PHASE -1
#endif
#define RUNP(idx, call) do { _Pragma("nounroll") for (int rep_ = 0; rep_ < launder_s(DBL_PHASE == (idx) ? 2 : 1); ++rep_) { call; } } while (0)
constexpr int ATT_LDS_ALL = ATT_LDS + 8 * 12 * 64 * 16;
constexpr int DYN_LDS = ATT_LDS_ALL;
static_assert(DYN_LDS >= GEMM_LDS && DYN_LDS >= SCAN_LDS && DYN_LDS <= 160 * 1024 - 512, "LDS budget");
__global__ void __launch_bounds__(NTHR) k_mega(Params pa) {
  cg::grid_group grid = cg::this_grid();
  extern __shared__ __attribute__((aligned(16))) unsigned char smem[];
  __shared__ uint4 xb_words;
  if (threadIdx.x < 35) s_ptr[threadIdx.x] = (unsigned long long)pa.in[threadIdx.x];
  if (threadIdx.x == 0) { xb_words = make_uint4(0u, 0u, 0u, 0u); s_tc[0] = 0; s_tc[1] = 0; }
  __syncthreads();
  PT p; p.out = pa.out; p.ws = pa.ws;
  const XcdBarrier xbar = xcd_barrier_post((unsigned*)(pa.ws + WS_BAR), (volatile LAS unsigned*)&xb_words);
  unsigned long long* ts = (unsigned long long*)(pa.ws + WS_TS);
  int nts = 0;
#define STAMP() do { if (PROBE_PHASE >= 0 && blockIdx.x == 0 && threadIdx.x == 0) ts[nts] = __builtin_amdgcn_s_memrealtime(); ++nts; } while (0)
#define GSYNC() do { if (USE_CG_SYNC) grid.sync(); else xcd_barrier(xbar); STAMP(); } while (0)
  STAMP();
  ph_mod2(p, smem);
  grid.sync();
  STAMP();
#pragma nounroll
  for (int l = 0; l < DEPTH; ++l) {
    if (l == 0) { RUNP(1, ph_prenorm_v(p, l)); GSYNC(); }
    RUNP(2, ph_gemm1(p, l, smem));        GSYNC();
    RUNP(3, ph_mla_lora(p, l, smem));     GSYNC();
    unsigned long long ck0_ = 0, rk0_ = 0;
    if (PROBE_PHASE == 70 && blockIdx.x == 0 && threadIdx.x == 0) { ck0_ = __builtin_amdgcn_s_memtime(); rk0_ = __builtin_amdgcn_s_memrealtime(); }
    unsigned long long ta0_ = 0;
    if (PROBE_PHASE == 80 && blockIdx.x == 64 && threadIdx.x == 0) ta0_ = __builtin_amdgcn_s_memrealtime();
    ph_p4_scan(p, l, smem);               STAMP();
    if (PROBE_PHASE == 70 && blockIdx.x == 0 && threadIdx.x == 0 && l == 0) { const unsigned long long ck1_ = __builtin_amdgcn_s_memtime(), rk1_ = __builtin_amdgcn_s_memrealtime(); s_tc[0] = (ck1_ - ck0_) * 1000ull / (rk1_ - rk0_); }
    ph_p4_queue(p, l, smem);              STAMP();
    if (PROBE_PHASE == 80 && blockIdx.x == 64 && threadIdx.x == 0) atomicAdd(&ts[40], __builtin_amdgcn_s_memrealtime() - ta0_);
    GSYNC();
    RUNP(7, ph_rwkvout_v(p, l));          GSYNC();
    RUNP(8, ph_wout(p, l, smem));         GSYNC();
    ph_postmix_v(p, l, smem);             GSYNC();
    RUNP(10, ph_moe_up(p, l, smem));      GSYNC();
    RUNP(11, ph_moe_down(p, l, smem));    GSYNC();
    ph_postffn_v(p, l);                   GSYNC();
    if (DBL_PHASE == 20) { for (int q_ = 0; q_ < 10; ++q_) GSYNC(); }
  }
  if (PROBE_PHASE >= 0 && blockIdx.x == 0 && threadIdx.x == 0) {
    unsigned long long t = 0;
    const int k = PROBE_PHASE;
    if (k == 80) t = __hip_atomic_load(&ts[40], __ATOMIC_RELAXED, __HIP_MEMORY_SCOPE_AGENT);
    else if (k == 70) t = s_tc[0];
    else if (k >= 50) t = s_tc[k - 50];
    else if (k == 0) t = ts[1] - ts[0];
    else { t = ts[1 + k] - ts[k]; if (k >= 2) t += ts[12 + k] - ts[11 + k]; }
    const unsigned long long t0 = __builtin_amdgcn_s_memrealtime();
    while (__builtin_amdgcn_s_memrealtime() - t0 < t) __builtin_amdgcn_s_sleep(8);
  }
}

extern "C" void kernel_launch(void* const* d_in, const int* in_sizes, int n_in, void* d_out, int out_size, void* d_ws, size_t ws_size,
                              hipStream_t stream) {
  static int grid_blocks = 0;
  if (!grid_blocks) {
    int dev = 0, cus = 0, per_cu = 0;
    (void)hipGetDevice(&dev);
    (void)hipDeviceGetAttribute(&cus, hipDeviceAttributeMultiprocessorCount, dev);
    (void)hipFuncSetAttribute((const void*)k_mega, hipFuncAttributeMaxDynamicSharedMemorySize, DYN_LDS);
    (void)hipOccupancyMaxActiveBlocksPerMultiprocessor(&per_cu, (const void*)k_mega, NTHR, DYN_LDS);
    if (per_cu < 1) per_cu = 1;
    grid_blocks = cus;
    if (ws_size < WS_END) fprintf(stderr, "kernel_launch: workspace too small: %zu < %zu\n", ws_size, (size_t)WS_END);
  }
  Params p{};
  for (int i = 0; i < 35; ++i) p.in[i] = (const float*)d_in[i];
  p.out = (float*)d_out; p.ws = (unsigned char*)d_ws;
  (void)hipMemsetAsync((char*)d_ws + WS_CTL, 0, 65536, stream);
  void* args[] = {&p};
  hipError_t e = hipLaunchCooperativeKernel((const void*)k_mega, dim3(grid_blocks), dim3(NTHR), args, DYN_LDS, stream);
  if (e != hipSuccess) fprintf(stderr, "cooperative launch failed: %s (grid %d)\n", hipGetErrorString(e), grid_blocks);
}
```

```cpp
#include <hip/hip_runtime.h>
#include <hip/hip_cooperative_groups.h>
#include <stdint.h>
#include <stdio.h>
namespace cg = cooperative_groups;

#define DI __device__ __forceinline__
#define SC_DBL 0
#ifndef XM
#define XM 3
#endif
#ifndef SCX
#define SCX -1
#endif
#ifndef PROBE_PHASE
#define PROBE_PHASE -1
#endif
typedef unsigned short bf16_t;

constexpr int D = 1024, NB = 4, SEQ = 4096, CTX = 256, DEPTH = 2;
constexpr int NLAT = NB * SEQ;
constexpr int NCTX = NB * CTX;
constexpr int NT = NLAT + NCTX;
constexpr int KEYS = SEQ + CTX;
constexpr int HEADS = 8;
constexpr int IN_COLS = 2368, MLA_COLS = 416, RW_COLS = 1952;
constexpr int NEXP = 16;
constexpr int NTHR = 512;
constexpr float EPS = 1e-6f;
constexpr float QSCALE = 0.10206207261596577f;

constexpr size_t WS_CTL  = 0;
constexpr size_t WS_MOD  = 65536;
constexpr size_t WS_XC   = WS_MOD + 2 * 5 * 6144 * 4;
constexpr size_t WS_TOPK = WS_XC + (size_t)NCTX * D * 4;
constexpr size_t WS_INV  = WS_TOPK + (size_t)NT * 16;
constexpr size_t WS_BUFA = WS_INV + (size_t)NEXP * NT * 4;
constexpr size_t WS_P    = WS_BUFA + (size_t)NT * 1024 * 2;
constexpr size_t WS_Q    = WS_P + (size_t)NT * IN_COLS * 2;
constexpr size_t WS_KN   = WS_Q + (size_t)NT * 768 * 2;
constexpr size_t WS_VT   = WS_KN + (size_t)NT * 512 * 2;
constexpr size_t WS_DEC  = WS_VT + (size_t)NT * 512 * 2;
constexpr size_t WS_AA   = WS_DEC + (size_t)NT * 1024 * 2;
constexpr size_t WS_KR   = WS_AA + (size_t)NT * 1024 * 2;
constexpr size_t WS_END  = WS_KR + (size_t)NT * 32 * 2;
static_assert(WS_END <= (size_t)256 * 1024 * 1024, "workspace over 256 MiB");
constexpr size_t WS_Y    = WS_P;
constexpr size_t WS_ACTS = WS_P + (size_t)NT * 1024 * 2;
constexpr size_t WS_ACTR = WS_ACTS + (size_t)NT * 256 * 2;
constexpr size_t WS_FS   = WS_Q;
constexpr size_t WS_R    = WS_DEC;
constexpr size_t WS_RW   = WS_DEC;
static_assert(WS_ACTR + (size_t)2 * NT * 256 * 2 <= WS_Q, "act overflow");
static_assert(WS_FS + (size_t)NT * 1024 * 2 <= WS_DEC, "fs overflow");

struct Params {
  const float* in[35];
  float* out;
  unsigned char* ws;
};
__shared__ unsigned long long s_ptr[40];
__shared__ unsigned long long s_tc[2];
struct PT;
struct PT {
  struct In { DI const float* operator[](int i) const {
      unsigned long long v = s_ptr[i];
      unsigned lo = __builtin_amdgcn_readfirstlane((unsigned)v), hi = __builtin_amdgcn_readfirstlane((unsigned)(v >> 32));
      return (const float*)(const __attribute__((address_space(1))) float*)(((unsigned long long)hi << 32) | lo); } } in;
  float* out;
  unsigned char* ws;
};
DI int launder_v(int x) { asm volatile("" : "+v"(x)); return x; }
DI int launder_s(int x) { asm volatile("" : "+s"(x)); return x; }
DI PT launder(const PT& q) {
  unsigned long long o = (unsigned long long)q.out, w = (unsigned long long)q.ws;
  asm volatile("" : "+s"(o), "+s"(w));
  PT r; r.out = (float*)(__attribute__((address_space(1))) float*)o; r.ws = (unsigned char*)(__attribute__((address_space(1))) unsigned char*)w;
  return r;
}

enum { I_X = 0, I_C, I_CTX, I_CCTX, I_ADAW, I_ADAB, I_MIXPRE, I_MIXPOST, I_FFNPRE, I_FFNPOST, I_WIN, I_QNG, I_KVNG, I_WUQ, I_WUKV,
       I_MU, I_W0, I_W2, I_A0, I_A2, I_G2, I_KK, I_KA, I_RK, I_LNG, I_LNB, I_WOUT, I_RW, I_RB, I_EG, I_EU, I_ED, I_SG, I_SU, I_SD };

DI float bf2f(bf16_t h) { return __uint_as_float(((unsigned)h) << 16); }
typedef __attribute__((ext_vector_type(2))) float f32x2;
typedef __attribute__((ext_vector_type(2))) __bf16 bf16x2_t;
DI unsigned pack2(float a, float b) { f32x2 v = {a, b}; bf16x2_t r = __builtin_convertvector(v, bf16x2_t); return __builtin_bit_cast(unsigned, r); }
DI bf16_t f2bf(float x) { return (bf16_t)pack2(x, x); }
DI float frcp(float x) { return __builtin_amdgcn_rcpf(x); }
DI float sigm(float x) { return 1.f / (1.f + expf(-x)); }
DI float siluf(float x) { return x / (1.f + expf(-x)); }
template <int CTRL> DI float dpp_add(float v) { int t = __builtin_amdgcn_update_dpp(0, __float_as_int(v), CTRL, 0xf, 0xf, true); return v + __int_as_float(t); }
DI float sum16_dpp(float v) { v = dpp_add<0x128>(v); v = dpp_add<0x124>(v); v = dpp_add<0x122>(v); v = dpp_add<0x121>(v); return v; }
DI float rdlane(float v, int l) { return __int_as_float(__builtin_amdgcn_readlane(__float_as_int(v), l)); }
DI float wave_sum(float v) {
  v = sum16_dpp(v);
  return (rdlane(v, 0) + rdlane(v, 16)) + (rdlane(v, 32) + rdlane(v, 48));
}
DI float sum16(float v) {
#pragma unroll
  for (int o = 8; o > 0; o >>= 1) v += __shfl_xor(v, o);
  return v;
}

struct RowInfo { int b, t, len, ctx; };
DI RowInfo rinfo(int r) {
  RowInfo q;
  if (r < NLAT) { q.b = r >> 12; q.t = r & 4095; q.len = SEQ; q.ctx = 0; }
  else { int u = r - NLAT; q.b = u >> 8; q.t = u & 255; q.len = CTX; q.ctx = 1; }
  return q;
}
DI int keyidx(const RowInfo& q) { return q.ctx ? SEQ + q.t : q.t; }
DI int modrow(const RowInfo& q) { return q.ctx ? 4 : q.b; }

DI float ps_val(const bf16_t* P, const float* mu, int r, const RowInfo& q, int c) {
  size_t o = (size_t)r * IN_COLS + MLA_COLS + c;
  float pc = bf2f(P[o]);
  float pv = q.t > 0 ? bf2f(P[o - IN_COLS]) : 0.f;
  float nx = q.t < q.len - 1 ? bf2f(P[o + IN_COLS]) : 0.f;
  return pc + mu[c] * (pv - pc) + mu[RW_COLS + c] * (nx - pc);
}

DI void ph_mod(const PT& p_) {
  const PT p = launder(p_); const int TID = launder_v(threadIdx.x); const int BID = launder_s(blockIdx.x); (void)TID; (void)BID;
  for (int i = BID * NTHR + TID; i < DEPTH * 6144; i += gridDim.x * NTHR) {
  int l = i / 6144, n = i % 6144;
  const float* c = p.in[I_C]; const float* cc = p.in[I_CCTX];
  const float* W = p.in[I_ADAW] + (size_t)l * 1024 * 6144;
  float bias = p.in[I_ADAB][l * 6144 + n];
  float acc[5];
#pragma unroll
  for (int r = 0; r < 5; ++r) acc[r] = bias;
  for (int k = 0; k < 1024; ++k) {
    float w = W[(size_t)k * 6144 + n];
#pragma unroll
    for (int r = 0; r < 4; ++r) acc[r] += siluf(c[r * 1024 + k]) * w;
    acc[4] += siluf(cc[k]) * w;
  }
  float* MOD = (float*)(p.ws + WS_MOD);
#pragma unroll
  for (int r = 0; r < 5; ++r) MOD[(size_t)(l * 5 + r) * 6144 + n] = acc[r];
  }
}

DI void ph_prenorm(const PT& p_, int l) {
  const PT p = launder(p_); const int TID = launder_v(threadIdx.x); const int BID = launder_s(blockIdx.x); (void)TID; (void)BID;
  const int lane = TID & 63;
  for (int r = (BID * NTHR + TID) >> 6; r < NT; r += (gridDim.x * NTHR) >> 6) {
  RowInfo q = rinfo(r);
  const float* xrow = q.ctx ? ((l == 0 ? p.in[I_CTX] : (const float*)(p.ws + WS_XC)) + (size_t)(r - NLAT) * D)
                            : ((l == 0 ? p.in[I_X] : (const float*)p.out) + (size_t)r * D);
  float v[16]; float ss = 0.f;
#pragma unroll
  for (int i = 0; i < 16; ++i) { v[i] = xrow[lane + 64 * i]; ss += v[i] * v[i]; }
  ss = wave_sum(ss);
  float rstd = rsqrtf(ss * (1.f / 1024.f) + EPS);
  const float* g = p.in[I_MIXPRE] + l * D;
  const float* mod = (const float*)(p.ws + WS_MOD) + (size_t)(l * 5 + modrow(q)) * 6144;
  bf16_t* H = (bf16_t*)(p.ws + WS_BUFA) + (size_t)r * D;
#pragma unroll
  for (int i = 0; i < 16; ++i) { int k = lane + 64 * i; H[k] = f2bf(v[i] * rstd * g[k] * (1.f + mod[1024 + k]) + mod[k]); }
  }
}

DI void gemm_naive(const bf16_t* A, int lda, const float* W, int ldw, bf16_t* C, int ldc, int M, int N, int K) {
  const int TID = launder_v(threadIdx.x); const int BID = launder_s(blockIdx.x);
  for (long idx = (long)BID * NTHR + TID; idx < (long)M * N; idx += (long)gridDim.x * NTHR) {
  int r = (int)(idx / N), n = (int)(idx % N);
  const bf16_t* a = A + (size_t)r * lda;
  float acc = 0.f;
  for (int k = 0; k < K; ++k) acc += bf2f(a[k]) * W[(size_t)k * ldw + n];
  C[(size_t)r * ldc + n] = f2bf(acc);
  }
}

DI void rope_pair(float a1, float a2, int i, const RowInfo& q, float& o1, float& o2) {
  if (q.ctx) { o1 = a1; o2 = a2; return; }
  float pos = (float)((i < 8) ? (q.t >> 6) : (q.t & 63));
  float fr = __builtin_amdgcn_exp2f(-(float)(i & 7) * 1.6609640474436813f);
  float ang = pos * fr, c = __cosf(ang), s = __sinf(ang);
  o1 = a1 * c - a2 * s; o2 = a1 * s + a2 * c;
}
DI void ph_mla(const PT& p_, int l) {
  const PT p = launder(p_); const int TID = launder_v(threadIdx.x); const int BID = launder_s(blockIdx.x); (void)TID; (void)BID;
  for (long idx = (long)BID * NTHR + TID; idx < (long)NT * 1680; idx += (long)gridDim.x * NTHR) {
  int r = (int)(idx / 1680), j = (int)(idx % 1680);
  RowInfo q = rinfo(r);
  const bf16_t* prow = (const bf16_t*)(p.ws + WS_P) + (size_t)r * IN_COLS;
  bf16_t* Q = (bf16_t*)(p.ws + WS_Q) + (size_t)r * 768;
  int kr = q.b * KEYS + keyidx(q);
  if (j < 640) {
    int hh = j / 80, jj = j % 80;
    float ss = 0.f;
    for (int k = 0; k < 256; ++k) { float v = bf2f(prow[k]); ss += v * v; }
    float rs = rsqrtf(ss * (1.f / 256.f) + EPS);
    const float* gq = p.in[I_QNG] + l * 256; const float* W = p.in[I_WUQ] + (size_t)l * 256 * 768;
    if (jj < 64) {
      int n = hh * 96 + jj; float acc = 0.f;
      for (int k = 0; k < 256; ++k) acc += bf2f(prow[k]) * rs * gq[k] * W[k * 768 + n];
      Q[n] = f2bf(acc * QSCALE);
    } else {
      int i = jj - 64, n1 = hh * 96 + 64 + i, n2 = n1 + 16; float a1 = 0.f, a2 = 0.f;
      for (int k = 0; k < 256; ++k) { float v = bf2f(prow[k]) * rs * gq[k]; a1 += v * W[k * 768 + n1]; a2 += v * W[k * 768 + n2]; }
      float o1, o2; rope_pair(a1, a2, i, q, o1, o2);
      Q[n1] = f2bf(o1 * QSCALE); Q[n2] = f2bf(o2 * QSCALE);
    }
  } else if (j < 1664) {
    int n = j - 640, hh = n >> 7, jj = n & 127;
    float ss = 0.f;
    for (int k = 0; k < 128; ++k) { float v = bf2f(prow[256 + k]); ss += v * v; }
    float rs = rsqrtf(ss * (1.f / 128.f) + EPS);
    const float* gk = p.in[I_KVNG] + l * 128; const float* W = p.in[I_WUKV] + (size_t)l * 128 * 1024;
    float acc = 0.f;
    for (int k = 0; k < 128; ++k) acc += bf2f(prow[256 + k]) * rs * gk[k] * W[k * 1024 + n];
    if (jj < 64) ((bf16_t*)(p.ws + WS_KN))[((size_t)kr * 8 + hh) * 64 + jj] = f2bf(acc);
    else ((bf16_t*)(p.ws + WS_VT))[((size_t)(q.b * 8 + hh) * 64 + (jj - 64)) * KEYS + keyidx(q)] = f2bf(acc);
  } else {
    int i = j - 1664;
    float a1 = bf2f(prow[384 + i]), a2 = bf2f(prow[384 + 16 + i]), o1, o2;
    rope_pair(a1, a2, i, q, o1, o2);
    bf16_t* KR = (bf16_t*)(p.ws + WS_KR) + (size_t)kr * 32;
    KR[i] = f2bf(o1); KR[16 + i] = f2bf(o2);
  }
  }
}

DI void ph_lora(const PT& p_, int l) {
  const PT p = launder(p_); const int TID = launder_v(threadIdx.x); const int BID = launder_s(blockIdx.x); (void)TID; (void)BID;
  for (long idx = (long)BID * NTHR + TID; idx < (long)NT * 2048; idx += (long)gridDim.x * NTHR) {
  int r = (int)(idx >> 11), j = (int)(idx & 2047);
  int kind = j >> 9, c = j & 511;
  RowInfo q = rinfo(r);
  const bf16_t* P = (const bf16_t*)(p.ws + WS_P);
  const float* mu = p.in[I_MU] + (size_t)l * 2 * RW_COLS;
  if (kind < 2) {
    int d = kind;
    float z = p.in[I_W0][(l * 2 + d) * 512 + c];
    const float* w2 = p.in[I_W2] + (size_t)(l * 2 + d) * 64 * 512;
    for (int jj = 0; jj < 64; ++jj) z += tanhf(ps_val(P, mu, r, q, 1536 + d * 64 + jj)) * w2[jj * 512 + c];
    ((bf16_t*)(p.ws + WS_DEC))[((size_t)r * 2 + d) * 512 + c] = f2bf(0.6065306597126334f * sigm(z));
  } else {
    int d = kind - 2;
    float z = p.in[I_A0][(l * 2 + d) * 512 + c];
    const float* a2 = p.in[I_A2] + (size_t)(l * 2 + d) * 64 * 512;
    for (int jj = 0; jj < 64; ++jj) z += ps_val(P, mu, r, q, 1664 + d * 64 + jj) * a2[jj * 512 + c];
    ((bf16_t*)(p.ws + WS_AA))[((size_t)r * 2 + d) * 512 + c] = f2bf(sigm(z));
  }
  }
}

DI void ph_attn_naive(const PT& p_) {
  const PT p = launder(p_); const int TID = launder_v(threadIdx.x); const int BID = launder_s(blockIdx.x); (void)TID; (void)BID;
  const int lane = TID & 63;
  const bf16_t* KN = (const bf16_t*)(p.ws + WS_KN);
  const bf16_t* KR = (const bf16_t*)(p.ws + WS_KR);
  for (int wv = (BID * NTHR + TID) >> 6; wv < NT * 8; wv += (gridDim.x * NTHR) >> 6) {
    int r = wv >> 3, h = wv & 7;
    RowInfo q = rinfo(r);
    bf16_t* Q = (bf16_t*)(p.ws + WS_Q) + (size_t)r * 768 + h * 96;
    unsigned qp[48];
#pragma unroll
    for (int d = 0; d < 48; ++d) qp[d] = ((const unsigned*)Q)[d];
    const bf16_t* VT = (const bf16_t*)(p.ws + WS_VT) + ((size_t)(q.b * 8 + h) * 64 + lane) * KEYS;
    float m = -1e30f, ls = 0.f, o = 0.f;
    for (int k0 = q.ctx ? SEQ : 0; k0 < KEYS; k0 += 64) {
      int kr = q.b * KEYS + k0 + lane;
      const unsigned* kn = (const unsigned*)(KN + ((size_t)kr * 8 + h) * 64);
      const unsigned* krp = (const unsigned*)(KR + (size_t)kr * 32);
      float s = 0.f;
#pragma unroll
      for (int d = 0; d < 32; ++d) { unsigned kq = kn[d]; s += __uint_as_float(qp[d] << 16) * __uint_as_float(kq << 16) + __uint_as_float(qp[d] & 0xffff0000u) * __uint_as_float(kq & 0xffff0000u); }
#pragma unroll
      for (int d = 0; d < 16; ++d) { unsigned kq = krp[d]; s += __uint_as_float(qp[32 + d] << 16) * __uint_as_float(kq << 16) + __uint_as_float(qp[32 + d] & 0xffff0000u) * __uint_as_float(kq & 0xffff0000u); }
      float mx = s;
#pragma unroll
      for (int off = 32; off > 0; off >>= 1) mx = fmaxf(mx, __shfl_xor(mx, off));
      float mn = fmaxf(m, mx);
      float al = expf(m - mn), pp = expf(s - mn);
      ls = ls * al + wave_sum(pp);
      o *= al; m = mn;
      for (int k = 0; k < 64; ++k) o += __shfl(pp, k) * bf2f(VT[k0 + k]);
    }
    Q[lane] = f2bf(o / ls);
  }
}

DI void ph_scan_naive(const PT& p_, int l) {
  const PT p = launder(p_); const int TID = launder_v(threadIdx.x); const int BID = launder_s(blockIdx.x); (void)TID; (void)BID;
  if (BID >= 128) return;
  int job = BID >> 1, half = BID & 1;
  int d = job & 1, h = (job >> 1) & 7, b = job >> 4;
  int w = TID >> 6, lane = TID & 63;
  int i = half * 32 + w * 4 + (lane >> 4), part = lane & 15;
  const bf16_t* P = (const bf16_t*)(p.ws + WS_P);
  const bf16_t* DEC = (const bf16_t*)(p.ws + WS_DEC);
  const bf16_t* AA = (const bf16_t*)(p.ws + WS_AA);
  bf16_t* YS = (bf16_t*)(p.ws + WS_BUFA) + (size_t)d * NT * 512;
  const float* mu = p.in[I_MU] + (size_t)l * 2 * RW_COLS;
  float kkw[4], kaw[4];
#pragma unroll
  for (int j = 0; j < 4; ++j) { kkw[j] = p.in[I_KK][l * 512 + h * 64 + part * 4 + j]; kaw[j] = p.in[I_KA][l * 512 + h * 64 + part * 4 + j]; }
  float S[4] = {0.f, 0.f, 0.f, 0.f};
  for (int step = 0; step < CTX + SEQ; ++step) {
    int r;
    if (step < CTX) { int t = d ? (CTX - 1 - step) : step; r = NLAT + b * CTX + t; }
    else { int s2 = step - CTX; int t = d ? (SEQ - 1 - s2) : s2; r = b * SEQ + t; }
    RowInfo q = rinfo(r);
    float rr[4], kraw[4], kk[4], aa[4], wd[4];
    float ss = 0.f;
#pragma unroll
    for (int j = 0; j < 4; ++j) {
      int c = h * 64 + part * 4 + j;
      rr[j] = ps_val(P, mu, r, q, c);
      kraw[j] = ps_val(P, mu, r, q, 512 + c);
      aa[j] = bf2f(AA[((size_t)r * 2 + d) * 512 + c]);
      wd[j] = expf(-bf2f(DEC[((size_t)r * 2 + d) * 512 + c]));
      kk[j] = kraw[j] * kkw[j]; ss += kk[j] * kk[j];
    }
    float vv = ps_val(P, mu, r, q, 1024 + h * 64 + i);
    ss = sum16(ss);
    float rn = rsqrtf(ss + 1e-12f);
    float sk = 0.f;
#pragma unroll
    for (int j = 0; j < 4; ++j) { kk[j] *= rn; sk += S[j] * kk[j]; }
    sk = sum16(sk);
    float y = 0.f;
#pragma unroll
    for (int j = 0; j < 4; ++j) {
      float keff = kraw[j] * (1.f + (aa[j] - 1.f) * kaw[j]);
      S[j] = S[j] * wd[j] - sk * (kk[j] * aa[j]) + vv * keff;
      y += S[j] * rr[j];
    }
    y = sum16(y);
    if (part == 0) YS[(size_t)r * 512 + h * 64 + i] = f2bf(y);
  }
}

DI void ph_rwkvout(const PT& p_, int l) {
  const PT p = launder(p_); const int TID = launder_v(threadIdx.x); const int BID = launder_s(blockIdx.x); (void)TID; (void)BID;
  const int lane = TID & 63;
  for (int wv = (BID * NTHR + TID) >> 6; wv < NT * 8; wv += (gridDim.x * NTHR) >> 6) {
  int r = wv >> 3, h = wv & 7, c = h * 64 + lane;
  RowInfo q = rinfo(r);
  const bf16_t* P = (const bf16_t*)(p.ws + WS_P);
  const bf16_t* AA = (const bf16_t*)(p.ws + WS_AA);
  const bf16_t* YS = (const bf16_t*)(p.ws + WS_BUFA);
  const float* mu = p.in[I_MU] + (size_t)l * 2 * RW_COLS;
  float y = bf2f(YS[(size_t)r * 512 + c]) + bf2f(YS[(size_t)NT * 512 + (size_t)r * 512 + c]);
  float mean = wave_sum(y) * (1.f / 64.f);
  float dv = y - mean;
  float var = wave_sum(dv * dv) * (1.f / 64.f);
  float yn = dv * rsqrtf(var + 64e-5f) * p.in[I_LNG][l * 512 + c] + p.in[I_LNB][l * 512 + c];
  float rr = ps_val(P, mu, r, q, c), kraw = ps_val(P, mu, r, q, 512 + c), vv = ps_val(P, mu, r, q, 1024 + c);
  float ka = p.in[I_KA][l * 512 + c];
  float a0 = bf2f(AA[((size_t)r * 2 + 0) * 512 + c]), a1 = bf2f(AA[((size_t)r * 2 + 1) * 512 + c]);
  float keffsum = kraw * (1.f + (a0 - 1.f) * ka) + kraw * (1.f + (a1 - 1.f) * ka);
  float bonus = wave_sum(rr * keffsum * p.in[I_RK][l * 512 + c]);
  const float* g2 = p.in[I_G2] + (size_t)l * 160 * 512;
  float g = 0.f;
  for (int j = 0; j < 160; ++j) g += sigm(ps_val(P, mu, r, q, 1792 + j)) * g2[j * 512 + c];
  ((bf16_t*)(p.ws + WS_RW))[(size_t)r * 512 + c] = f2bf((yn + bonus * vv) * g);
  }
}

DI void ph_wout_naive(const PT& p_, int l) {
  const PT p = launder(p_); const int TID = launder_v(threadIdx.x); const int BID = launder_s(blockIdx.x); (void)TID; (void)BID;
  for (long idx = (long)BID * NTHR + TID; idx < (long)NT * 1024; idx += (long)gridDim.x * NTHR) {
  int r = (int)(idx >> 10), n = (int)(idx & 1023);
  const bf16_t* Q = (const bf16_t*)(p.ws + WS_Q) + (size_t)r * 768;
  const bf16_t* RW = (const bf16_t*)(p.ws + WS_RW) + (size_t)r * 512;
  const float* W = p.in[I_WOUT] + (size_t)l * 1024 * 1024;
  float acc = 0.f;
  for (int k = 0; k < 512; ++k) acc += bf2f(Q[(k >> 6) * 96 + (k & 63)]) * W[(size_t)k * 1024 + n];
  for (int k = 0; k < 512; ++k) acc += bf2f(RW[k]) * W[(size_t)(512 + k) * 1024 + n];
  ((bf16_t*)(p.ws + WS_Y))[(size_t)r * 1024 + n] = f2bf(acc);
  }
}

DI void ph_postmix(const PT& p_, int l) {
  const PT p = launder(p_); const int TID = launder_v(threadIdx.x); const int BID = launder_s(blockIdx.x); (void)TID; (void)BID;
  const int lane = TID & 63;
  for (int r = (BID * NTHR + TID) >> 6; r < NT; r += (gridDim.x * NTHR) >> 6) {
  RowInfo q = rinfo(r);
  const float* xin = q.ctx ? ((l == 0 ? p.in[I_CTX] : (const float*)(p.ws + WS_XC)) + (size_t)(r - NLAT) * D)
                           : ((l == 0 ? p.in[I_X] : (const float*)p.out) + (size_t)r * D);
  float* xout = q.ctx ? ((float*)(p.ws + WS_XC) + (size_t)(r - NLAT) * D) : (p.out + (size_t)r * D);
  const bf16_t* Y = (const bf16_t*)(p.ws + WS_Y) + (size_t)r * D;
  const float* mod = (const float*)(p.ws + WS_MOD) + (size_t)(l * 5 + modrow(q)) * 6144;
  float yv[16], xv[16]; float ss = 0.f;
#pragma unroll
  for (int i = 0; i < 16; ++i) { yv[i] = bf2f(Y[lane + 64 * i]); ss += yv[i] * yv[i]; }
  ss = wave_sum(ss);
  float rstd = rsqrtf(ss * (1.f / 1024.f) + EPS);
  const float* gpost = p.in[I_MIXPOST] + l * D;
  float s2 = 0.f;
#pragma unroll
  for (int i = 0; i < 16; ++i) { int k = lane + 64 * i; xv[i] = xin[k] + mod[2 * 1024 + k] * (yv[i] * rstd * gpost[k]); s2 += xv[i] * xv[i]; xout[k] = xv[i]; }
  s2 = wave_sum(s2);
  float rstd2 = rsqrtf(s2 * (1.f / 1024.f) + EPS);
  const float* gpre = p.in[I_FFNPRE] + l * D;
  bf16_t* H2 = (bf16_t*)(p.ws + WS_BUFA) + (size_t)r * D;
  const float* RWt = p.in[I_RW];
  float lg[16];
#pragma unroll
  for (int e = 0; e < 16; ++e) lg[e] = 0.f;
#pragma unroll
  for (int i = 0; i < 16; ++i) {
    int k = lane + 64 * i;
    float hv = xv[i] * rstd2 * gpre[k] * (1.f + mod[4 * 1024 + k]) + mod[3 * 1024 + k];
    H2[k] = f2bf(hv);
#pragma unroll
    for (int e = 0; e < 16; ++e) lg[e] += hv * RWt[k * 16 + e];
  }
#pragma unroll
  for (int e = 0; e < 16; ++e) lg[e] = wave_sum(lg[e]);
  if (lane == 0) {
    float sc[16], bi[16];
#pragma unroll
    for (int e = 0; e < 16; ++e) { sc[e] = sigm(lg[e]); bi[e] = sc[e] + p.in[I_RB][e]; }
    float bgs = -1e30f; int e1 = 0, e2 = 0; float w1 = 0.f, w2 = 0.f;
#pragma unroll
    for (int g = 0; g < 4; ++g) {
      float m1 = -1e30f, m2 = -1e30f, s1v = 0.f, s2v = 0.f; int i1 = 0, i2 = 0;
#pragma unroll
      for (int j = 0; j < 4; ++j) {
        float v = bi[g * 4 + j], s = sc[g * 4 + j];
        if (v > m1) { m2 = m1; i2 = i1; s2v = s1v; m1 = v; i1 = j; s1v = s; }
        else if (v > m2) { m2 = v; i2 = j; s2v = s; }
      }
      float gs = m1 + m2;
      if (gs > bgs) { bgs = gs; e1 = g * 4 + i1; e2 = g * 4 + i2; w1 = s1v; w2 = s2v; }
    }
    float inv = 1.f / (w1 + w2);
    int* CNT = (int*)(p.ws + WS_CTL) + l * 16;
    int* INV = (int*)(p.ws + WS_INV);
    int s1 = atomicAdd(&CNT[e1], 1), sl2 = atomicAdd(&CNT[e2], 1);
    INV[(size_t)e1 * NT + s1] = r; INV[(size_t)e2 * NT + sl2] = r;
    int* POS = (int*)(p.ws + WS_TOPK); float* GW = (float*)(p.ws + WS_TOPK + (size_t)NT * 8);
    POS[r * 2] = (e1 << 20) | s1; POS[r * 2 + 1] = (e2 << 20) | sl2;
    GW[r * 2] = w1 * inv; GW[r * 2 + 1] = w2 * inv;
  }
  }
}

DI int expert_off(const int* CNT, int e) { int a = 0; for (int t = 0; t < 16; ++t) a += (t < e) ? CNT[t] : 0; return a; }
DI void expert_of_row(const int* CNT, int sr, int& e, int& base) { int a = 0; e = 0; base = 0; for (int t = 0; t < 16; ++t) { if (sr >= a) { e = t; base = a; } a += CNT[t]; } }

DI void ph_moe_up_naive(const PT& p_, int l) {
  const PT p = launder(p_); const int TID = launder_v(threadIdx.x); const int BID = launder_s(blockIdx.x); (void)TID; (void)BID;
  for (long idx = (long)BID * NTHR + TID; idx < (long)3 * NT * 256; idx += (long)gridDim.x * NTHR) {
  int row = (int)(idx >> 8), j = (int)(idx & 255);
  const bf16_t* H2 = (const bf16_t*)(p.ws + WS_BUFA);
  if (row < NT) {
    const bf16_t* h = H2 + (size_t)row * D;
    const float* wg = p.in[I_SG] + (size_t)l * 1024 * 256; const float* wu = p.in[I_SU] + (size_t)l * 1024 * 256;
    float g = 0.f, u = 0.f;
    for (int k = 0; k < 1024; ++k) { float hv = bf2f(h[k]); g += hv * wg[k * 256 + j]; u += hv * wu[k * 256 + j]; }
    ((bf16_t*)(p.ws + WS_ACTS))[(size_t)row * 256 + j] = f2bf(siluf(g) * u);
  } else {
    int sr = row - NT;
    const int* CNT = (const int*)(p.ws + WS_CTL) + l * 16;
    int e, base; expert_of_row(CNT, sr, e, base);
    int r = ((const int*)(p.ws + WS_INV))[(size_t)e * NT + (sr - base)];
    const bf16_t* h = H2 + (size_t)r * D;
    const float* wg = p.in[I_EG] + (size_t)(l * 16 + e) * 1024 * 256; const float* wu = p.in[I_EU] + (size_t)(l * 16 + e) * 1024 * 256;
    float g = 0.f, u = 0.f;
    for (int k = 0; k < 1024; ++k) { float hv = bf2f(h[k]); g += hv * wg[k * 256 + j]; u += hv * wu[k * 256 + j]; }
    ((bf16_t*)(p.ws + WS_ACTR))[(size_t)sr * 256 + j] = f2bf(siluf(g) * u);
  }
  }
}

DI void ph_moe_down_naive(const PT& p_, int l) {
  const PT p = launder(p_); const int TID = launder_v(threadIdx.x); const int BID = launder_s(blockIdx.x); (void)TID; (void)BID;
  for (long idx = (long)BID * NTHR + TID; idx < (long)3 * NT * 1024; idx += (long)gridDim.x * NTHR) {
  int row = (int)(idx >> 10), n = (int)(idx & 1023);
  if (row < NT) {
    const bf16_t* a = (const bf16_t*)(p.ws + WS_ACTS) + (size_t)row * 256;
    const float* wd = p.in[I_SD] + (size_t)l * 256 * 1024;
    float acc = 0.f;
    for (int k = 0; k < 256; ++k) acc += bf2f(a[k]) * wd[k * 1024 + n];
    ((bf16_t*)(p.ws + WS_FS))[(size_t)row * 1024 + n] = f2bf(acc);
  } else {
    int sr = row - NT;
    const int* CNT = (const int*)(p.ws + WS_CTL) + l * 16;
    int e, base; expert_of_row(CNT, sr, e, base);
    const bf16_t* a = (const bf16_t*)(p.ws + WS_ACTR) + (size_t)sr * 256;
    const float* wd = p.in[I_ED] + (size_t)(l * 16 + e) * 256 * 1024;
    float acc = 0.f;
    for (int k = 0; k < 256; ++k) acc += bf2f(a[k]) * wd[k * 1024 + n];
    ((bf16_t*)(p.ws + WS_R))[(size_t)sr * 1024 + n] = f2bf(acc);
  }
  }
}

DI void ph_postffn(const PT& p_, int l) {
  const PT p = launder(p_); const int TID = launder_v(threadIdx.x); const int BID = launder_s(blockIdx.x); (void)TID; (void)BID;
  const int lane = TID & 63;
  for (int r = (BID * NTHR + TID) >> 6; r < NT; r += (gridDim.x * NTHR) >> 6) {
  RowInfo q = rinfo(r);
  float* x = q.ctx ? ((float*)(p.ws + WS_XC) + (size_t)(r - NLAT) * D) : (p.out + (size_t)r * D);
  const int* CNT = (const int*)(p.ws + WS_CTL) + l * 16;
  const int* POS = (const int*)(p.ws + WS_TOPK); const float* GW = (const float*)(p.ws + WS_TOPK + (size_t)NT * 8);
  int p1 = POS[r * 2], p2 = POS[r * 2 + 1];
  size_t r1 = (size_t)(expert_off(CNT, p1 >> 20) + (p1 & 0xFFFFF)), r2 = (size_t)(expert_off(CNT, p2 >> 20) + (p2 & 0xFFFFF));
  float w1 = GW[r * 2], w2 = GW[r * 2 + 1];
  const bf16_t* FS = (const bf16_t*)(p.ws + WS_FS) + (size_t)r * D;
  const bf16_t* R1 = (const bf16_t*)(p.ws + WS_R) + r1 * D;
  const bf16_t* R2 = (const bf16_t*)(p.ws + WS_R) + r2 * D;
  const float* mod = (const float*)(p.ws + WS_MOD) + (size_t)(l * 5 + modrow(q)) * 6144;
  const float* g = p.in[I_FFNPOST] + l * D;
  float f[16]; float ss = 0.f;
#pragma unroll
  for (int i = 0; i < 16; ++i) { int k = lane + 64 * i; f[i] = bf2f(FS[k]) + w1 * bf2f(R1[k]) + w2 * bf2f(R2[k]); ss += f[i] * f[i]; }
  ss = wave_sum(ss);
  float rstd = rsqrtf(ss * (1.f / 1024.f) + EPS);
#pragma unroll
  for (int i = 0; i < 16; ++i) { int k = lane + 64 * i; x[k] = x[k] + mod[5 * 1024 + k] * (f[i] * rstd * g[k]); }
  }
}


typedef __attribute__((ext_vector_type(8))) short bf16x8;
typedef __attribute__((ext_vector_type(4))) float f32x4;

constexpr int BM = 256, BN = 128, BK = 64, LDT = BK;
constexpr int GEMM_BUF = (BM + BN) * LDT;
constexpr int GEMM_LDS = 2 * GEMM_BUF * 2;

DI float sumsq8(const uint4& v) {
  float a = 0.f;
  const unsigned u[4] = {v.x, v.y, v.z, v.w};
#pragma unroll
  for (int i = 0; i < 4; ++i) { float lo = __uint_as_float(u[i] << 16), hi = __uint_as_float(u[i] & 0xffff0000u); a += lo * lo + hi * hi; }
  return a;
}
template <class Op>
DI void gemm_tile(const Op& op, unsigned char* smem, const int TID) {
  bf16_t* base = (bf16_t*)smem;
  const int tid = launder_v(TID), lane = tid & 63, w = tid >> 6, wm = w >> 1, wn = w & 1, l15 = lane & 15, g = lane >> 4;
  const int arow = tid >> 3, akc = tid & 7;
  const int bkg = ((tid >> 7) << 2) | (tid & 3), bng = (tid >> 2) & 31;
  f32x4 acc[4][4];
#pragma unroll
  for (int i = 0; i < 4; ++i)
#pragma unroll
    for (int j = 0; j < 4; ++j) acc[i][j] = (f32x4){0.f, 0.f, 0.f, 0.f};
  uint4 ra0[4], ra1[4]; float4 rb0[4], rb1[4];
  float ssq[4] = {0.f, 0.f, 0.f, 0.f};
  const int KT = op.K / BK;
#define G_LOAD(RA, RB, kt_) do { const int k0_ = (kt_) * BK; \
    _Pragma("unroll") for (int i = 0; i < 4; ++i) RA[i] = op.a_load(i, arow + 64 * i, k0_ + akc * 8); \
    _Pragma("unroll") for (int j = 0; j < 4; ++j) RB[j] = op.b_load(k0_ + bkg * 4 + j, bng * 4); } while (0)
#define G_STORE(RA, RB, buf_) do { bf16_t* As_ = base + (buf_) * GEMM_BUF; bf16_t* Bs_ = As_ + BM * LDT; \
    _Pragma("unroll") for (int i = 0; i < 4; ++i) { *(uint4*)(As_ + (arow + 64 * i) * LDT + ((akc ^ (((arow + 64 * i) >> 1) & 7)) * 8)) = RA[i]; if (Op::ROWSS) ssq[i] += sumsq8(RA[i]); } \
    _Pragma("unroll") for (int nn = 0; nn < 4; ++nn) { uint2 v_; v_.x = pack2(((const float*)&RB[0])[nn], ((const float*)&RB[1])[nn]); v_.y = pack2(((const float*)&RB[2])[nn], ((const float*)&RB[3])[nn]); \
      *(uint2*)(Bs_ + (bng * 4 + nn) * LDT + (((bkg >> 1) ^ (((bng * 4 + nn) >> 1) & 7)) * 8) + (bkg & 1) * 4) = v_; } } while (0)
#define G_COMPUTE(buf_) do { const bf16_t* As_ = base + (buf_) * GEMM_BUF; const bf16_t* Bs_ = As_ + BM * LDT; \
    _Pragma("unroll") for (int kk = 0; kk < 2; ++kk) { bf16x8 af[4], bfr[4]; \
      _Pragma("unroll") for (int i = 0; i < 4; ++i) af[i] = *(const bf16x8*)(As_ + (wm * 64 + i * 16 + l15) * LDT + (((kk * 4 + g) ^ (l15 >> 1)) * 8)); \
      _Pragma("unroll") for (int j = 0; j < 4; ++j) bfr[j] = *(const bf16x8*)(Bs_ + (wn * 64 + j * 16 + l15) * LDT + (((kk * 4 + g) ^ (l15 >> 1)) * 8)); \
      _Pragma("unroll") for (int i = 0; i < 4; ++i) _Pragma("unroll") for (int j = 0; j < 4; ++j) acc[i][j] = __builtin_amdgcn_mfma_f32_16x16x32_bf16(af[i], bfr[j], acc[i][j], 0, 0, 0); } } while (0)
  unsigned long long tg0 = 0, tg1 = 0;
  if (PROBE_PHASE >= 50 && PROBE_PHASE < 60) tg0 = __builtin_amdgcn_s_memrealtime();
  G_LOAD(ra0, rb0, 0);
  G_LOAD(ra1, rb1, min(1, KT - 1));
  G_STORE(ra0, rb0, 0);
  __syncthreads();
  for (int kt = 0; kt < KT; kt += 2) {
    G_LOAD(ra0, rb0, min(kt + 2, KT - 1));
    __builtin_amdgcn_sched_barrier(0);
    if (kt + 1 < KT) G_STORE(ra1, rb1, 1);
    G_COMPUTE(0);
    __syncthreads();
    if (kt + 1 >= KT) break;
    G_LOAD(ra1, rb1, min(kt + 3, KT - 1));
    __builtin_amdgcn_sched_barrier(0);
    if (kt + 2 < KT) G_STORE(ra0, rb0, 0);
    G_COMPUTE(1);
    __syncthreads();
  }
#undef G_LOAD
#undef G_STORE
#undef G_COMPUTE
  if (PROBE_PHASE >= 50 && PROBE_PHASE < 60) tg1 = __builtin_amdgcn_s_memrealtime();
  float* rowss = (float*)(smem + GEMM_LDS);
  if (Op::ROWSS) {
#pragma unroll
    for (int i = 0; i < 4; ++i) {
      float v = ssq[i];
      v += __shfl_xor(v, 1); v += __shfl_xor(v, 2); v += __shfl_xor(v, 4);
      if (akc == 0) rowss[arow + 64 * i] = v;
    }
    __syncthreads();
  }
#if defined(DBL_EPI)
  _Pragma("nounroll") for (int rep_ = 0; rep_ < launder_s(2); ++rep_)
#endif
  op.epilogue(acc, launder_v(wm), launder_v(wn), launder_v(l15), launder_v(g), rowss);
  if (Op::ROWSS) __syncthreads();
  if (PROBE_PHASE >= 50 && PROBE_PHASE < 60) {
    asm volatile("s_waitcnt vmcnt(0)" ::: "memory");
    const unsigned long long tg2 = __builtin_amdgcn_s_memrealtime();
    if (blockIdx.x == 0 && tid == 0) { s_tc[0] += tg1 - tg0; s_tc[1] += tg2 - tg1; }
  }
}

DI int rows_after_mixer(int l) { return (l + 1 < DEPTH) ? NT : NLAT; }
DI int vblock(int bid) { const int G = gridDim.x; return (G & 7) ? bid : (bid & 7) * (G >> 3) + (bid >> 3); }
DI void band_tile(int q, int TM, int TN, int MB, int& mt, int& nt) {
  const int per = MB * TN; const int band = q / per, rem = q - band * per; const int mb = min(MB, TM - band * MB);
  nt = rem / mb; mt = band * MB + (rem - nt * mb);
}
struct OpGemm1 {
  static constexpr bool ROWSS = false;
  static constexpr int K = 1024;
  const bf16_t* A; const float* W; bf16_t* C; int m0, n0;
  DI uint4 a_load(int i, int row, int k) const { return *(const uint4*)(A + (size_t)(m0 + row) * 1024 + k); }
  DI float4 b_load(int k, int n) const { int col = min(n0 + n, IN_COLS - 4); return *(const float4*)(W + (size_t)k * IN_COLS + col); }
  DI void epilogue(const f32x4 (&acc)[4][4], int wm, int wn, int l15, int g, const float* rowss) const {
#pragma unroll
    for (int i = 0; i < 4; ++i)
#pragma unroll
      for (int j = 0; j < 4; ++j) {
        int col = n0 + wn * 64 + j * 16 + l15;
        if (col < IN_COLS) {
#pragma unroll
          for (int r = 0; r < 4; ++r) C[(size_t)(m0 + wm * 64 + i * 16 + g * 4 + r) * IN_COLS + col] = f2bf(acc[i][j][r]);
        }
      }
  }
};
DI void ph_gemm1(const PT& p_, int l, unsigned char* smem) {
  const PT p = launder(p_); const int TID = launder_v(threadIdx.x); const int BID = launder_s(blockIdx.x); (void)TID; (void)BID;
  const bf16_t* A = (const bf16_t*)(p.ws + WS_BUFA); const float* W = p.in[I_WIN] + (size_t)l * 1024 * IN_COLS; bf16_t* C = (bf16_t*)(p.ws + WS_P);
  constexpr int TN = (IN_COLS + BN - 1) / BN, TM = NT / BM;
  for (int t = vblock(BID); t < TM * TN; t += gridDim.x) { int mt, nt; band_tile(t, TM, TN, 1, mt, nt); const OpGemm1 op{A, W, C, mt * BM, nt * BN}; gemm_tile(op, smem, TID); }
}

struct OpWout {
  static constexpr bool ROWSS = false;
  static constexpr int K = 1024;
  const bf16_t* Qb; const bf16_t* RWb; const float* W; bf16_t* C; int m0, n0;
  DI uint4 a_load(int i, int row, int k) const {
    size_t r = (size_t)(m0 + row);
    return k < 512 ? *(const uint4*)(Qb + r * 768 + (k >> 6) * 96 + (k & 63)) : *(const uint4*)(RWb + r * 512 + (k - 512));
  }
  DI float4 b_load(int k, int n) const { return *(const float4*)(W + (size_t)k * 1024 + n0 + n); }
  DI void epilogue(const f32x4 (&acc)[4][4], int wm, int wn, int l15, int g, const float* rowss) const {
#pragma unroll
    for (int i = 0; i < 4; ++i)
#pragma unroll
      for (int j = 0; j < 4; ++j) {
        int col = n0 + wn * 64 + j * 16 + l15;
#pragma unroll
        for (int r = 0; r < 4; ++r) C[(size_t)(m0 + wm * 64 + i * 16 + g * 4 + r) * 1024 + col] = f2bf(acc[i][j][r]);
      }
  }
};
DI void ph_wout(const PT& p_, int l, unsigned char* smem) {
  const PT p = launder(p_); const int TID = launder_v(threadIdx.x); const int BID = launder_s(blockIdx.x); (void)TID; (void)BID;
  const bf16_t* Qb = (const bf16_t*)(p.ws + WS_Q); const bf16_t* RWb = (const bf16_t*)(p.ws + WS_RW); const float* W = p.in[I_WOUT] + (size_t)l * 1024 * 1024; bf16_t* C = (bf16_t*)(p.ws + WS_Y);
  constexpr int TN = 1024 / BN; const int TM = rows_after_mixer(l) / BM;
  for (int t = vblock(BID); t < TM * TN; t += gridDim.x) { int mt, nt; band_tile(t, TM, TN, 4, mt, nt); const OpWout op{Qb, RWb, W, C, mt * BM, nt * BN}; gemm_tile(op, smem, TID); }
}

struct OpMoeUp {
  static constexpr bool ROWSS = false;
  static constexpr int K = 1024;
  const bf16_t* H2; const float* Wg; const float* Wu; bf16_t* C;
  int m0, nrows, jbase; size_t out_row0;
  int s0, s1, s2, s3;
  DI uint4 a_load(int i, int row, int k) const {
    int sr = i == 0 ? s0 : i == 1 ? s1 : i == 2 ? s2 : s3;
    return *(const uint4*)(H2 + (size_t)max(sr, 0) * 1024 + k);
  }
  DI float4 b_load(int k, int n) const {
    int j = jbase + (n >> 6) * 32 + ((n >> 4) & 1) * 16 + (n & 15);
    const float* W = ((n >> 5) & 1) ? Wu : Wg;
    return *(const float4*)(W + (size_t)k * 256 + j);
  }
  DI void epilogue(const f32x4 (&acc)[4][4], int wm, int wn, int l15, int g, const float* rowss) const {
#pragma unroll
    for (int i = 0; i < 4; ++i)
#pragma unroll
      for (int j = 0; j < 2; ++j) {
        int col = jbase + wn * 32 + j * 16 + l15;
#pragma unroll
        for (int r = 0; r < 4; ++r) {
          int lr = m0 + wm * 64 + i * 16 + g * 4 + r;
          if (lr < nrows) { float gv = acc[i][j][r], uv = acc[i][j + 2][r]; C[(out_row0 + lr) * 256 + col] = f2bf(gv * frcp(1.f + __expf(-gv)) * uv); }
        }
      }
  }
};
DI void ph_moe_up(const PT& p_, int l, unsigned char* smem) {
  const PT p = launder(p_); const int TID = launder_v(threadIdx.x); const int BID = launder_s(blockIdx.x); (void)TID; (void)BID;
  const int* CNT = (const int*)(p.ws + WS_CTL) + l * 16;
  constexpr int TNU = 4;
  const int NR = rows_after_mixer(l);
  const int shared_tiles = (NR / BM) * TNU;
  int tot = shared_tiles;
  for (int e = 0; e < 16; ++e) tot += ((CNT[e] + BM - 1) / BM) * TNU;
  const bf16_t* H2 = (const bf16_t*)(p.ws + WS_BUFA);
  const int* INVb = (const int*)(p.ws + WS_INV);
  const int arow = TID >> 3;
  for (int t = vblock(BID); t < tot; t += gridDim.x) {
    int e = -1, tb = 0, off = 0, at = shared_tiles, ar = 0;
    for (int q = 0; q < 16; ++q) { int c = CNT[q]; int nt = ((c + BM - 1) / BM) * TNU; if (t >= at && t < at + nt) { e = q; tb = at; off = ar; } at += nt; ar += c; }
    const bool sh = e < 0;
    const int lt = t - tb;
    const int m0 = (lt / TNU) * BM, nrows = sh ? NR : CNT[e];
    const size_t wo = sh ? (size_t)l * 1024 * 256 : (size_t)(l * 16 + e) * 1024 * 256;
    const float* Wg = (sh ? p.in[I_SG] : p.in[I_EG]) + wo;
    const float* Wu = (sh ? p.in[I_SU] : p.in[I_EU]) + wo;
    bf16_t* C = (bf16_t*)(p.ws + (sh ? WS_ACTS : WS_ACTR));
    const int* inv = INVb + (size_t)(sh ? 0 : e) * NT;
    int sr[4];
#pragma unroll
    for (int i = 0; i < 4; ++i) { int lr = m0 + arow + 64 * i; sr[i] = lr < nrows ? (sh ? lr : inv[lr]) : -1; }
    const OpMoeUp op{H2, Wg, Wu, C, m0, nrows, (lt % TNU) * 64, (size_t)off, sr[0], sr[1], sr[2], sr[3]};
    gemm_tile(op, smem, TID);
  }
}

struct OpMoeDown {
  static constexpr bool ROWSS = false;
  static constexpr int K = 256;
  const bf16_t* A; const float* W; bf16_t* C; int m0, nrows, n0; size_t row0;
  DI uint4 a_load(int i, int row, int k) const { int lr = min(m0 + row, nrows - 1); return *(const uint4*)(A + (row0 + lr) * 256 + k); }
  DI float4 b_load(int k, int n) const { return *(const float4*)(W + (size_t)k * 1024 + n0 + n); }
  DI void epilogue(const f32x4 (&acc)[4][4], int wm, int wn, int l15, int g, const float* rowss) const {
#pragma unroll
    for (int i = 0; i < 4; ++i)
#pragma unroll
      for (int j = 0; j < 4; ++j) {
        int col = n0 + wn * 64 + j * 16 + l15;
#pragma unroll
        for (int r = 0; r < 4; ++r) { int lr = m0 + wm * 64 + i * 16 + g * 4 + r; if (lr < nrows) C[(row0 + lr) * 1024 + col] = f2bf(acc[i][j][r]); }
      }
  }
};
DI void ph_moe_down(const PT& p_, int l, unsigned char* smem) {
  const PT p = launder(p_); const int TID = launder_v(threadIdx.x); const int BID = launder_s(blockIdx.x); (void)TID; (void)BID;
  const int* CNT = (const int*)(p.ws + WS_CTL) + l * 16;
  constexpr int TND = 1024 / BN;
  const int NR = rows_after_mixer(l);
  const int shared_tiles = (NR / BM) * TND;
  int tot = shared_tiles;
  for (int e = 0; e < 16; ++e) tot += ((CNT[e] + BM - 1) / BM) * TND;
  for (int t = vblock(BID); t < tot; t += gridDim.x) {
    int e = -1, tb = 0, off = 0, at = shared_tiles, ar = 0;
    for (int q = 0; q < 16; ++q) { int c = CNT[q]; int nt = ((c + BM - 1) / BM) * TND; if (t >= at && t < at + nt) { e = q; tb = at; off = ar; } at += nt; ar += c; }
    const bool sh = e < 0;
    const int lt = t - tb;
    const bf16_t* A = (const bf16_t*)(p.ws + (sh ? WS_ACTS : WS_ACTR));
    const float* W = sh ? p.in[I_SD] + (size_t)l * 256 * 1024 : p.in[I_ED] + (size_t)(l * 16 + e) * 256 * 1024;
    bf16_t* C = (bf16_t*)(p.ws + (sh ? WS_FS : WS_R));
    const OpMoeDown op{A, W, C, (lt / TND) * BM, sh ? NR : CNT[e], (lt % TND) * BN, (size_t)off};
    gemm_tile(op, smem, TID);
  }
}


constexpr int KS_LD = 104, VS_LD = 72;
constexpr int ATT_BUF = 64 * KS_LD + 64 * VS_LD;
constexpr int ATT_LDS = 2 * ATT_BUF * 2;
constexpr float LOG2E = 1.4426950408889634f;

DI void attn_item(const PT& p, unsigned char* smem, const int TID, int b, int h, int qrow0, int nw, int key0, int nkt) {
  bf16_t* base = (bf16_t*)smem;
  const int lane = TID & 63, w = TID >> 6, l15 = lane & 15, g = lane >> 4;
  const bool active = w < nw;
  bf16_t* Qg = (bf16_t*)(p.ws + WS_Q);
  const bf16_t* KN = (const bf16_t*)(p.ws + WS_KN);
  const bf16_t* KR = (const bf16_t*)(p.ws + WS_KR);
  const bf16_t* VT = (const bf16_t*)(p.ws + WS_VT) + (size_t)(b * 8 + h) * 64 * KEYS;
  bf16x8* qlds = (bf16x8*)(smem + ATT_LDS) + w * 12 * 64 + lane;
  if (active) {
#pragma unroll
    for (int qt = 0; qt < 4; ++qt)
#pragma unroll
      for (int ks = 0; ks < 3; ++ks)
        qlds[(qt * 3 + ks) * 64] = *(const bf16x8*)(Qg + (size_t)(qrow0 + w * 64 + qt * 16 + l15) * 768 + h * 96 + ks * 32 + g * 8);
  }
  f32x4 oacc[4][4];
#pragma unroll
  for (int i = 0; i < 4; ++i)
#pragma unroll
    for (int j = 0; j < 4; ++j) oacc[i][j] = (f32x4){0.f, 0.f, 0.f, 0.f};
  float mrun[4], lsum[4];
#pragma unroll
  for (int i = 0; i < 4; ++i) { mrun[i] = -1e30f; lsum[i] = 0.f; }
  const int skey = TID >> 3, sc8 = TID & 7;
  const int lrow = (skey & ~31) | (((skey >> 2) & 1) << 4) | (((skey >> 3) & 3) << 2) | (skey & 3);
  const int rkey = (TID & 255) >> 2, rc = TID & 3;
  const int rlrow = (rkey & ~31) | (((rkey >> 2) & 1) << 4) | (((rkey >> 3) & 3) << 2) | (rkey & 3);
  uint4 r_kn, r_kr, r_vt;
  r_kr = make_uint4(0u, 0u, 0u, 0u);
  {
    const size_t kr0 = (size_t)b * KEYS + key0;
    r_kn = *(const uint4*)(KN + ((kr0 + skey) * 8 + h) * 64 + sc8 * 8);
    if (TID < 256) r_kr = *(const uint4*)(KR + (kr0 + rkey) * 32 + rc * 8);
    r_vt = *(const uint4*)(VT + (size_t)skey * KEYS + key0 + sc8 * 8);
    bf16_t* Ks = base; bf16_t* Vs = base + 64 * KS_LD;
    *(uint4*)(Ks + lrow * KS_LD + sc8 * 8) = r_kn;
    if (TID < 256) *(uint4*)(Ks + rlrow * KS_LD + 64 + rc * 8) = r_kr;
    *(uint4*)(Vs + skey * VS_LD + sc8 * 8) = r_vt;
  }
  __syncthreads();
  for (int t = 0; t < nkt; ++t) {
    const bf16_t* Ks = base + (t & 1) * ATT_BUF; const bf16_t* Vs = Ks + 64 * KS_LD;
    const bool more = (t + 1 < nkt);
    if (more) {
      const int k0 = key0 + (t + 1) * 64;
      const size_t kr0 = (size_t)b * KEYS + k0;
      r_kn = *(const uint4*)(KN + ((kr0 + skey) * 8 + h) * 64 + sc8 * 8);
      if (TID < 256) r_kr = *(const uint4*)(KR + (kr0 + rkey) * 32 + rc * 8);
      r_vt = *(const uint4*)(VT + (size_t)skey * KEYS + k0 + sc8 * 8);
    }
    if (active) {
#pragma unroll 1
      for (int s2 = 0; s2 < 2; ++s2) {
        f32x4 sacc[2][4];
#pragma unroll
        for (int i = 0; i < 2; ++i)
#pragma unroll
          for (int j = 0; j < 4; ++j) sacc[i][j] = (f32x4){0.f, 0.f, 0.f, 0.f};
#pragma unroll
        for (int ks = 0; ks < 3; ++ks) {
          bf16x8 kf[2];
#pragma unroll
          for (int kt = 0; kt < 2; ++kt) kf[kt] = *(const bf16x8*)(Ks + ((2 * s2 + kt) * 16 + l15) * KS_LD + ks * 32 + g * 8);
#pragma unroll
          for (int qt = 0; qt < 4; ++qt) {
            const bf16x8 qf = qlds[(qt * 3 + ks) * 64];
#pragma unroll
            for (int kt = 0; kt < 2; ++kt) sacc[kt][qt] = __builtin_amdgcn_mfma_f32_16x16x32_bf16(kf[kt], qf, sacc[kt][qt], 0, 0, 0);
          }
        }
        bf16x8 vf[4];
#pragma unroll
        for (int vt = 0; vt < 4; ++vt) vf[vt] = *(const bf16x8*)(Vs + (vt * 16 + l15) * VS_LD + s2 * 32 + g * 8);
#pragma unroll
        for (int qt = 0; qt < 4; ++qt) {
          float mx = sacc[0][qt][0];
#pragma unroll
          for (int kt = 0; kt < 2; ++kt)
#pragma unroll
            for (int r = 0; r < 4; ++r) mx = fmaxf(mx, sacc[kt][qt][r]);
          mx = fmaxf(mx, __shfl_xor(mx, 16));
          mx = fmaxf(mx, __shfl_xor(mx, 32));
          const float mn = fmaxf(mrun[qt], mx * LOG2E);
          const float alpha = __builtin_amdgcn_exp2f(mrun[qt] - mn);
          mrun[qt] = mn;
          float ls = lsum[qt] * alpha;
#pragma unroll
          for (int vt = 0; vt < 4; ++vt) oacc[vt][qt] *= alpha;
#pragma unroll
          for (int kt = 0; kt < 2; ++kt)
#pragma unroll
            for (int r = 0; r < 4; ++r) { float pv = __builtin_amdgcn_exp2f(sacc[kt][qt][r] * LOG2E - mn); ls += pv; sacc[kt][qt][r] = pv; }
          lsum[qt] = ls;
          uint4 pk;
          pk.x = pack2(sacc[0][qt][0], sacc[0][qt][1]); pk.y = pack2(sacc[0][qt][2], sacc[0][qt][3]);
          pk.z = pack2(sacc[1][qt][0], sacc[1][qt][1]); pk.w = pack2(sacc[1][qt][2], sacc[1][qt][3]);
          const bf16x8 pf = __builtin_bit_cast(bf16x8, pk);
#pragma unroll
          for (int vt = 0; vt < 4; ++vt) oacc[vt][qt] = __builtin_amdgcn_mfma_f32_16x16x32_bf16(vf[vt], pf, oacc[vt][qt], 0, 0, 0);
        }
      }
    }
    if (more) {
      bf16_t* Ks2 = base + ((t + 1) & 1) * ATT_BUF; bf16_t* Vs2 = Ks2 + 64 * KS_LD;
      *(uint4*)(Ks2 + lrow * KS_LD + sc8 * 8) = r_kn;
      if (TID < 256) *(uint4*)(Ks2 + rlrow * KS_LD + 64 + rc * 8) = r_kr;
      *(uint4*)(Vs2 + skey * VS_LD + sc8 * 8) = r_vt;
    }
    __syncthreads();
  }
  if (active) {
#pragma unroll
    for (int qt = 0; qt < 4; ++qt) {
      float l = lsum[qt];
      l += __shfl_xor(l, 16); l += __shfl_xor(l, 32);
      const float inv = 1.f / l;
      bf16_t* orow = Qg + (size_t)(qrow0 + w * 64 + qt * 16 + l15) * 768 + h * 96;
#pragma unroll
      for (int vt = 0; vt < 4; ++vt) {
        uint2 o2; o2.x = pack2(oacc[vt][qt][0] * inv, oacc[vt][qt][1] * inv); o2.y = pack2(oacc[vt][qt][2] * inv, oacc[vt][qt][3] * inv);
        *(uint2*)(orow + vt * 16 + 4 * g) = o2;
      }
    }
  }
}
DI void ph_attn(const PT& p_, unsigned char* smem) {
  const PT p = launder(p_); const int TID = launder_v(threadIdx.x); const int BID = launder_s(blockIdx.x); (void)TID; (void)BID;
  for (int item = BID; item < 256 + 32; item += gridDim.x) {
    const bool lat = item < 256;
    const int bh = lat ? (item & 31) : (item - 256), qb = item >> 5;
    const int b = bh >> 3, h = bh & 7;
    attn_item(p, smem, TID, b, h, lat ? b * SEQ + qb * 512 : NLAT + b * CTX, lat ? 8 : 4, lat ? 0 : SEQ, lat ? KEYS / 64 : CTX / 64);
  }
}

constexpr int SC_CH = 32, SC_STEP = 392;
constexpr int SCAN_LDS = 2 * SC_CH * SC_STEP * 4;

DI int scan_row(int b, int d, int st) {
  if (st < CTX) { int t = d ? (CTX - 1 - st) : st; return NLAT + b * CTX + t; }
  int s2 = st - CTX; int t = d ? (SEQ - 1 - s2) : s2; return b * SEQ + t;
}
struct ScanRaw { unsigned pc[3], pv[3], nx[3], aa, dec; };
DI void scan_fetch(const bf16_t* P, const bf16_t* DEC, const bf16_t* AA, int b, int h, int d, int st0, int pw, int lane, ScanRaw (&raw)[4]) {
  const int half = lane >> 5, c0 = h * 64 + 2 * (lane & 31);
#pragma unroll
  for (int i = 0; i < 4; ++i) {
    const int r = scan_row(b, d, st0 + pw * 8 + 2 * i + half);
    const RowInfo q = rinfo(r);
    const bf16_t* pr = P + (size_t)r * IN_COLS + MLA_COLS + c0;
    const int op = q.t > 0 ? -IN_COLS : 0, on = q.t < q.len - 1 ? IN_COLS : 0;
#pragma unroll
    for (int j = 0; j < 3; ++j) { raw[i].pc[j] = *(const unsigned*)(pr + j * 512); raw[i].pv[j] = *(const unsigned*)(pr + j * 512 + op); raw[i].nx[j] = *(const unsigned*)(pr + j * 512 + on); }
    raw[i].aa = *(const unsigned*)(AA + ((size_t)r * 2 + d) * 512 + c0);
    raw[i].dec = *(const unsigned*)(DEC + ((size_t)r * 2 + d) * 512 + c0);
  }
}
DI float blo(unsigned u) { return __uint_as_float(u << 16); }
DI float bhi(unsigned u) { return __uint_as_float(u & 0xffff0000u); }
struct ScanConst { float m0[3][2], m1[3][2], kkw[2], kaw[2]; };
DI void scan_emit(const ScanRaw (&raw)[4], const ScanConst& K, int b, int d, int st0, int pw, int lane, float* buf) {
  const int half = lane >> 5, l2 = lane & 31;
#pragma unroll
  for (int i = 0; i < 4; ++i) {
    const int s = pw * 8 + 2 * i + half;
    const int r = scan_row(b, d, st0 + s);
    const RowInfo q = rinfo(r);
    const float mp = q.t > 0 ? 1.f : 0.f, mn = q.t < q.len - 1 ? 1.f : 0.f;
    float v[3][2];
#pragma unroll
    for (int j = 0; j < 3; ++j) {
      const float c0 = blo(raw[i].pc[j]), c1 = bhi(raw[i].pc[j]);
      v[j][0] = c0 + K.m0[j][0] * (mp * blo(raw[i].pv[j]) - c0) + K.m1[j][0] * (mn * blo(raw[i].nx[j]) - c0);
      v[j][1] = c1 + K.m0[j][1] * (mp * bhi(raw[i].pv[j]) - c1) + K.m1[j][1] * (mn * bhi(raw[i].nx[j]) - c1);
    }
    const float a0 = blo(raw[i].aa), a1 = bhi(raw[i].aa);
    const float w0 = __expf(-blo(raw[i].dec)), w1 = __expf(-bhi(raw[i].dec));
    float k0 = v[1][0] * K.kkw[0], k1 = v[1][1] * K.kkw[1];
    float ss = sum16_dpp(k0 * k0 + k1 * k1);
    const float ssA = rdlane(ss, 0) + rdlane(ss, 16), ssB = rdlane(ss, 32) + rdlane(ss, 48);
    const float rn = rsqrtf((half ? ssB : ssA) + 1e-12f);
    k0 *= rn; k1 *= rn;
    const float b0 = k0 * a0, b1 = k1 * a1;
    const float e0 = v[1][0] * (1.f + (a0 - 1.f) * K.kaw[0]), e1 = v[1][1] * (1.f + (a1 - 1.f) * K.kaw[1]);
    const float brs = sum16_dpp(b0 * v[0][0] + b1 * v[0][1]), krs = sum16_dpp(e0 * v[0][0] + e1 * v[0][1]);
    float* rec = buf + s * SC_STEP + 2 * l2;
    *(float2*)(rec) = make_float2(k0, k1); *(float2*)(rec + 64) = make_float2(w0, w1); *(float2*)(rec + 128) = make_float2(b0, b1);
    *(float2*)(rec + 192) = make_float2(e0, e1); *(float2*)(rec + 256) = make_float2(w0 * v[0][0], w1 * v[0][1]); *(float2*)(rec + 320) = make_float2(v[2][0], v[2][1]);
    const float brA = rdlane(brs, 0) + rdlane(brs, 16), brB = rdlane(brs, 32) + rdlane(brs, 48);
    const float krA = rdlane(krs, 0) + rdlane(krs, 16), krB = rdlane(krs, 32) + rdlane(krs, 48);
    if (l2 == 0) *(float2*)(buf + s * SC_STEP + 384) = make_float2(half ? brB : brA, half ? krB : krA);
  }
}
DI void ph_scan(const PT& p_, int l, unsigned char* smem) {
  const PT p = launder(p_); const int TID = launder_v(threadIdx.x); const int BID = launder_s(blockIdx.x); (void)TID; (void)BID;
  float* sbuf = (float*)smem;
  const int lane = TID & 63, w = TID >> 6;
  const bf16_t* P = (const bf16_t*)(p.ws + WS_P);
  const bf16_t* DEC = (const bf16_t*)(p.ws + WS_DEC);
  const bf16_t* AA = (const bf16_t*)(p.ws + WS_AA);
  for (int item = BID; item < 256; item += gridDim.x) {
    const int job = item >> 2, quarter = item & 3;
    const int d = job & 1, h = (job >> 1) & 7, b = job >> 4;
    constexpr int NCH = (CTX + SEQ) / SC_CH;
    if (w >= 4) {
      const int pw = w - 4, c0 = h * 64 + 2 * (lane & 31);
      const float* mu = p.in[I_MU] + (size_t)l * 2 * RW_COLS;
      ScanConst K;
#pragma unroll
      for (int j = 0; j < 3; ++j)
#pragma unroll
        for (int e = 0; e < 2; ++e) { K.m0[j][e] = mu[j * 512 + c0 + e]; K.m1[j][e] = mu[RW_COLS + j * 512 + c0 + e]; }
#pragma unroll
      for (int e = 0; e < 2; ++e) { K.kkw[e] = p.in[I_KK][l * 512 + c0 + e]; K.kaw[e] = p.in[I_KA][l * 512 + c0 + e]; }
      ScanRaw cur[4], nxt[4];
      scan_fetch(P, DEC, AA, b, h, d, 0, pw, lane, cur);
      scan_fetch(P, DEC, AA, b, h, d, SC_CH, pw, lane, nxt);
      scan_emit(cur, K, b, d, 0, pw, lane, sbuf);
      __syncthreads();
      for (int ch = 0; ch < NCH; ch += 2) {
        if (ch + 2 < NCH) scan_fetch(P, DEC, AA, b, h, d, (ch + 2) * SC_CH, pw, lane, cur);
        scan_emit(nxt, K, b, d, (ch + 1) * SC_CH, pw, lane, sbuf + SC_CH * SC_STEP);
        __syncthreads();
        if (ch + 3 < NCH) scan_fetch(P, DEC, AA, b, h, d, (ch + 3) * SC_CH, pw, lane, nxt);
        if (ch + 2 < NCH) scan_emit(cur, K, b, d, (ch + 2) * SC_CH, pw, lane, sbuf);
        __syncthreads();
      }
    } else {
      const int grow = lane >> 4, part = lane & 15;
      const int row = quarter * 16 + w * 4 + grow;
      bf16_t* YS = (bf16_t*)(p.ws + WS_BUFA) + (size_t)d * NT * 512 + h * 64 + row;
      float S0 = 0.f, S1 = 0.f, S2 = 0.f, S3 = 0.f;
      __builtin_amdgcn_s_setprio(3);
      __syncthreads();
      for (int ch = 0; ch < NCH; ++ch) {
        const float* cb = sbuf + (ch & 1) * SC_CH * SC_STEP;
        float4 kk = *(const float4*)(cb + part * 4), wd = *(const float4*)(cb + 64 + part * 4), bv = *(const float4*)(cb + 128 + part * 4);
        float4 ke = *(const float4*)(cb + 192 + part * 4), wr = *(const float4*)(cb + 256 + part * 4);
        float vv = cb[320 + row]; float2 sc = *(const float2*)(cb + 384);
        float ykeep = 0.f;
#pragma unroll
        for (int s = 0; s < SC_CH; ++s) {
          float4 nkk = kk, nwd = wd, nbv = bv, nke = ke, nwr = wr; float nvv = vv; float2 nsc = sc;
          if (s + 1 < SC_CH) {
            const float* rec = cb + (s + 1) * SC_STEP;
            nkk = *(const float4*)(rec + part * 4); nwd = *(const float4*)(rec + 64 + part * 4); nbv = *(const float4*)(rec + 128 + part * 4);
            nke = *(const float4*)(rec + 192 + part * 4); nwr = *(const float4*)(rec + 256 + part * 4);
            nvv = rec[320 + row]; nsc = *(const float2*)(rec + 384);
          }
          float d1 = S0 * kk.x + S1 * kk.y + (S2 * kk.z + S3 * kk.w);
          float d2 = S0 * wr.x + S1 * wr.y + (S2 * wr.z + S3 * wr.w);
          d1 = sum16_dpp(d1); d2 = sum16_dpp(d2);
          const float y = d2 - d1 * sc.x + vv * sc.y;
          S0 = S0 * wd.x + (vv * ke.x - d1 * bv.x);
          S1 = S1 * wd.y + (vv * ke.y - d1 * bv.y);
          S2 = S2 * wd.z + (vv * ke.z - d1 * bv.z);
          S3 = S3 * wd.w + (vv * ke.w - d1 * bv.w);
          ykeep = (part == (s & 15)) ? y : ykeep;
          if ((s & 15) == 15) YS[(size_t)scan_row(b, d, ch * SC_CH + (s - 15) + part) * 512] = f2bf(ykeep);
          kk = nkk; wd = nwd; bv = nbv; ke = nke; wr = nwr; vv = nvv; sc = nsc;
        }
        __syncthreads();
      }
      __builtin_amdgcn_s_setprio(0);
    }
  }
}

struct OpMlaQ {
  static constexpr bool ROWSS = true;
  static constexpr int K = 256;
  const bf16_t* P; const float* W; const float* gq; bf16_t* Q; int m0, n0;
  DI uint4 a_load(int i, int row, int k) const { return *(const uint4*)(P + (size_t)(m0 + row) * IN_COLS + k); }
  DI float4 b_load(int k, int n) const { float4 v = *(const float4*)(W + (size_t)k * 768 + n0 + n); float gk = gq[k]; v.x *= gk; v.y *= gk; v.z *= gk; v.w *= gk; return v; }
  DI void epilogue(const f32x4 (&acc)[4][4], int wm, int wn, int l15, int g, const float* rowss) const {
    const int sidx0 = (n0 >> 4) + wn * 4, m6 = sidx0 % 6;
    const int jr = m6 == 4 ? 0 : (m6 == 2 ? 2 : -1);
    const float fr = __builtin_amdgcn_exp2f(-(float)(l15 & 7) * 1.6609640474436813f);
#pragma unroll
    for (int i = 0; i < 4; ++i) {
#pragma unroll
      for (int r = 0; r < 4; ++r) {
        const int lrow = wm * 64 + i * 16 + g * 4 + r, row = m0 + lrow;
        const float rs = rsqrtf(rowss[lrow] * (1.f / 256.f) + EPS) * QSCALE;
        float v0 = acc[i][0][r] * rs, v1 = acc[i][1][r] * rs, v2 = acc[i][2][r] * rs, v3 = acc[i][3][r] * rs;
        if (jr >= 0 && row < NLAT) {
          const int t = row & 4095;
          const float ang = (float)((l15 < 8) ? (t >> 6) : (t & 63)) * fr;
          const float c = __cosf(ang), sn = __sinf(ang);
          if (jr == 0) { const float a1 = v0, a2 = v1; v0 = a1 * c - a2 * sn; v1 = a1 * sn + a2 * c; }
          else { const float a1 = v2, a2 = v3; v2 = a1 * c - a2 * sn; v3 = a1 * sn + a2 * c; }
        }
        bf16_t* qo = Q + (size_t)row * 768 + sidx0 * 16 + l15;
        qo[0] = f2bf(v0); qo[16] = f2bf(v1); qo[32] = f2bf(v2); qo[48] = f2bf(v3);
        __builtin_amdgcn_sched_barrier(0);
      }
    }
  }
};
struct OpMlaKV {
  static constexpr bool ROWSS = true;
  static constexpr int K = 128;
  const bf16_t* P; const float* W; const float* gk; bf16_t* KN; bf16_t* VT; int m0, n0;
  DI uint4 a_load(int i, int row, int k) const { return *(const uint4*)(P + (size_t)(m0 + row) * IN_COLS + 256 + k); }
  DI float4 b_load(int k, int n) const { float4 v = *(const float4*)(W + (size_t)k * 1024 + n0 + n); float g_ = gk[k]; v.x *= g_; v.y *= g_; v.z *= g_; v.w *= g_; return v; }
  DI void epilogue(const f32x4 (&acc)[4][4], int wm, int wn, int l15, int g, const float* rowss) const {
    const int hh = n0 >> 7;
#pragma unroll
    for (int i = 0; i < 4; ++i) {
      const int lrow0 = wm * 64 + i * 16 + g * 4;
      const RowInfo q = rinfo(m0 + lrow0);
      const int kidx0 = keyidx(q);
      float rs[4];
#pragma unroll
      for (int r = 0; r < 4; ++r) rs[r] = rsqrtf(rowss[lrow0 + r] * (1.f / 128.f) + EPS);
      if (wn == 0) {
#pragma unroll
        for (int r = 0; r < 4; ++r)
#pragma unroll
          for (int j = 0; j < 4; ++j) KN[(((size_t)q.b * KEYS + kidx0 + r) * 8 + hh) * 64 + j * 16 + l15] = f2bf(acc[i][j][r] * rs[r]);
      } else {
#pragma unroll
        for (int j = 0; j < 4; ++j) {
          uint2 o; o.x = pack2(acc[i][j][0] * rs[0], acc[i][j][1] * rs[1]); o.y = pack2(acc[i][j][2] * rs[2], acc[i][j][3] * rs[3]);
          *(uint2*)(VT + ((size_t)(q.b * 8 + hh) * 64 + j * 16 + l15) * KEYS + kidx0) = o;
        }
      }
    }
  }
};
DI void ps8(const bf16_t* P, const float* mu, int r, const RowInfo& q, int c, float (&o)[8]) {
  const size_t off = (size_t)r * IN_COLS + MLA_COLS + c;
  const uint4 pc = *(const uint4*)(P + off);
  const bool hp = q.t > 0, hn = q.t < q.len - 1;
  uint4 pv = *(const uint4*)(P + off - (hp ? IN_COLS : 0)), nx = *(const uint4*)(P + off + (hn ? IN_COLS : 0));
  if (!hp) pv = make_uint4(0u, 0u, 0u, 0u);
  if (!hn) nx = make_uint4(0u, 0u, 0u, 0u);
  const float4 m0a = *(const float4*)(mu + c), m0b = *(const float4*)(mu + c + 4), m1a = *(const float4*)(mu + RW_COLS + c), m1b = *(const float4*)(mu + RW_COLS + c + 4);
  const unsigned uc[4] = {pc.x, pc.y, pc.z, pc.w}, up[4] = {pv.x, pv.y, pv.z, pv.w}, un[4] = {nx.x, nx.y, nx.z, nx.w};
  const float m0[8] = {m0a.x, m0a.y, m0a.z, m0a.w, m0b.x, m0b.y, m0b.z, m0b.w}, m1[8] = {m1a.x, m1a.y, m1a.z, m1a.w, m1b.x, m1b.y, m1b.z, m1b.w};
#pragma unroll
  for (int i = 0; i < 4; ++i) {
    float c0 = __uint_as_float(uc[i] << 16), c1 = __uint_as_float(uc[i] & 0xffff0000u);
    float p0 = __uint_as_float(up[i] << 16), p1 = __uint_as_float(up[i] & 0xffff0000u);
    float n0 = __uint_as_float(un[i] << 16), n1 = __uint_as_float(un[i] & 0xffff0000u);
    o[2 * i] = c0 + m0[2 * i] * (p0 - c0) + m1[2 * i] * (n0 - c0);
    o[2 * i + 1] = c1 + m0[2 * i + 1] * (p1 - c1) + m1[2 * i + 1] * (n1 - c1);
  }
}
DI float tanh_fast(float x) { float e = __expf(2.f * x); return 1.f - 2.f * frcp(e + 1.f); }
struct OpLora {
  static constexpr bool ROWSS = false;
  static constexpr int K = 64;
  const bf16_t* P; const float* mu; const float* W; const float* bias; bf16_t* OUT; int m0, n0, d, kind;
  DI uint4 a_load(int i, int row, int k) const {
    const int r = m0 + row; const RowInfo q = rinfo(r);
    float v[8]; ps8(P, mu, r, q, (kind ? 1664 : 1536) + d * 64 + k, v);
    if (kind == 0) {
#pragma unroll
      for (int e = 0; e < 8; ++e) v[e] = tanh_fast(v[e]);
    }
    uint4 o; o.x = pack2(v[0], v[1]); o.y = pack2(v[2], v[3]); o.z = pack2(v[4], v[5]); o.w = pack2(v[6], v[7]);
    return o;
  }
  DI float4 b_load(int k, int n) const { return *(const float4*)(W + (size_t)k * 512 + n0 + n); }
  DI void epilogue(const f32x4 (&acc)[4][4], int wm, int wn, int l15, int g, const float* rowss) const {
#pragma unroll
    for (int j = 0; j < 4; ++j) {
      const int col = n0 + wn * 64 + j * 16 + l15;
      const float bs = bias[col];
#pragma unroll
      for (int i = 0; i < 4; ++i)
#pragma unroll
        for (int r = 0; r < 4; ++r) {
          const int row = m0 + wm * 64 + i * 16 + g * 4 + r;
          float sg = frcp(1.f + __expf(-(acc[i][j][r] + bs)));
          OUT[((size_t)row * 2 + d) * 512 + col] = f2bf(kind ? sg : 1.f - __expf(-0.6065306597126334f * sg));
        }
    }
  }
};
DI int gcol(int c) { return c < 416 ? c : 1952 + (c - 416); }
struct OpGate {
  static constexpr bool ROWSS = false;
  static constexpr int K = 192;
  const bf16_t* P; const float* mu; const float* W; bf16_t* OUT; int m0, n0;
  DI uint4 a_load(int i, int row, int k) const {
    const int r = m0 + row; const RowInfo q = rinfo(r);
    float v[8]; ps8(P, mu, r, q, 1792 + min(k, 152), v);
#pragma unroll
    for (int e = 0; e < 8; ++e) v[e] = frcp(1.f + __expf(-v[e]));
    uint4 o; o.x = pack2(v[0], v[1]); o.y = pack2(v[2], v[3]); o.z = pack2(v[4], v[5]); o.w = pack2(v[6], v[7]);
    if (k >= 160) o = make_uint4(0u, 0u, 0u, 0u);
    return o;
  }
  DI float4 b_load(int k, int n) const { float4 v = *(const float4*)(W + (size_t)min(k, 159) * 512 + n0 + n); if (k >= 160) v = make_float4(0.f, 0.f, 0.f, 0.f); return v; }
  DI void epilogue(const f32x4 (&acc)[4][4], int wm, int wn, int l15, int g, const float* rowss) const {
#pragma unroll
    for (int i = 0; i < 4; ++i)
#pragma unroll
      for (int j = 0; j < 4; ++j)
#pragma unroll
        for (int r = 0; r < 4; ++r) OUT[(size_t)(m0 + wm * 64 + i * 16 + g * 4 + r) * IN_COLS + gcol(n0 + wn * 64 + j * 16 + l15)] = f2bf(acc[i][j][r]);
  }
};

DI void ld16f(const float* p, float (&v)[16]) {
#pragma unroll
  for (int i = 0; i < 4; ++i) { const float4 t = *(const float4*)(p + (i >> 1) * 512 + (i & 1) * 4); v[4 * i] = t.x; v[4 * i + 1] = t.y; v[4 * i + 2] = t.z; v[4 * i + 3] = t.w; }
}
DI void st16f(float* p, const float (&v)[16]) {
#pragma unroll
  for (int i = 0; i < 4; ++i) *(float4*)(p + (i >> 1) * 512 + (i & 1) * 4) = make_float4(v[4 * i], v[4 * i + 1], v[4 * i + 2], v[4 * i + 3]);
}
typedef float f4v_t __attribute__((ext_vector_type(4)));
DI void ld16f_nt(const float* p, float (&v)[16]) {
#pragma unroll
  for (int i = 0; i < 4; ++i) { const f4v_t t = __builtin_nontemporal_load((const f4v_t*)(p + (i >> 1) * 512 + (i & 1) * 4)); v[4 * i] = t.x; v[4 * i + 1] = t.y; v[4 * i + 2] = t.z; v[4 * i + 3] = t.w; }
}
DI void st16f_nt(float* p, const float (&v)[16]) {
#pragma unroll
  for (int i = 0; i < 4; ++i) { const f4v_t t = {v[4 * i], v[4 * i + 1], v[4 * i + 2], v[4 * i + 3]}; __builtin_nontemporal_store(t, (f4v_t*)(p + (i >> 1) * 512 + (i & 1) * 4)); }
}
template <int O, int N> DI void unpack8o(const uint4& u, float (&v)[N]) {
  v[O + 0] = blo(u.x); v[O + 1] = bhi(u.x); v[O + 2] = blo(u.y); v[O + 3] = bhi(u.y); v[O + 4] = blo(u.z); v[O + 5] = bhi(u.z); v[O + 6] = blo(u.w); v[O + 7] = bhi(u.w);
}
DI void unpack8(const uint4& u, float (&v)[8]) { unpack8o<0, 8>(u, v); }
typedef unsigned u4v_t __attribute__((ext_vector_type(4)));
DI uint4 ldu4_nt(const void* p) { const u4v_t a_ = __builtin_nontemporal_load((const u4v_t*)p); return make_uint4(a_.x, a_.y, a_.z, a_.w); }
DI void ld16b_nt(const bf16_t* p, float (&v)[16]) {
  const u4v_t a_ = __builtin_nontemporal_load((const u4v_t*)p), b_ = __builtin_nontemporal_load((const u4v_t*)(p + 512));
  const uint4 a = make_uint4(a_.x, a_.y, a_.z, a_.w), b = make_uint4(b_.x, b_.y, b_.z, b_.w);
  unpack8o<0, 16>(a, v); unpack8o<8, 16>(b, v);
}
DI void ld16b(const bf16_t* p, float (&v)[16]) { const uint4 a = *(const uint4*)p, b = *(const uint4*)(p + 512); unpack8o<0, 16>(a, v); unpack8o<8, 16>(b, v); }
template <int O, int N> DI uint4 pack8o(const float (&v)[N]) { uint4 o; o.x = pack2(v[O + 0], v[O + 1]); o.y = pack2(v[O + 2], v[O + 3]); o.z = pack2(v[O + 4], v[O + 5]); o.w = pack2(v[O + 6], v[O + 7]); return o; }
DI uint4 pack8(const float (&v)[8]) { return pack8o<0, 8>(v); }
DI void st16b(bf16_t* p, const float (&v)[16]) { *(uint4*)p = pack8o<0, 16>(v); *(uint4*)(p + 512) = pack8o<8, 16>(v); }

DI void norm_mod_store(const float (&x)[16], const float* g, const float* shift, const float* scale, bf16_t* dst) {
  float ss = 0.f;
#pragma unroll
  for (int i = 0; i < 16; ++i) ss += x[i] * x[i];
  ss = wave_sum(ss);
  const float rstd = rsqrtf(ss * (1.f / 1024.f) + EPS);
  float gv[16], sh[16], sc[16], h[16];
  ld16f(g, gv); ld16f(shift, sh); ld16f(scale, sc);
#pragma unroll
  for (int i = 0; i < 16; ++i) h[i] = x[i] * rstd * gv[i] * (1.f + sc[i]) + sh[i];
  st16b(dst, h);
}
DI void ph_prenorm_v(const PT& p_, int l) {
  const PT p = launder(p_); const int TID = launder_v(threadIdx.x); const int BID = launder_s(blockIdx.x); (void)TID; (void)BID;
  const int lane = TID & 63, k0 = lane * 8;
  for (int r = (BID * NTHR + TID) >> 6; r < NT; r += (gridDim.x * NTHR) >> 6) {
    const RowInfo q = rinfo(r);
    const float* xrow = q.ctx ? ((l == 0 ? p.in[I_CTX] : (const float*)(p.ws + WS_XC)) + (size_t)(r - NLAT) * D)
                              : ((l == 0 ? p.in[I_X] : (const float*)p.out) + (size_t)r * D);
    float x[16]; ld16f_nt(xrow + k0, x);
    const float* mod = (const float*)(p.ws + WS_MOD) + (size_t)(l * 5 + modrow(q)) * 6144;
    norm_mod_store(x, p.in[I_MIXPRE] + l * D + k0, mod + k0, mod + 1024 + k0, (bf16_t*)(p.ws + WS_BUFA) + (size_t)r * D + k0);
  }
}
DI void ph_postmix_v(const PT& p_, int l, unsigned char* smem) {
  const PT p = launder(p_); const int TID = launder_v(threadIdx.x); const int BID = launder_s(blockIdx.x); (void)TID; (void)BID;
  const int lane = TID & 63, k0 = lane * 8;
  float* wr = (float*)smem;
  for (int i = TID; i < 1024 * 16 / 4; i += NTHR) { const int k = i >> 2, e4 = i & 3; *(float4*)(wr + ((k & 511) >> 3) * 260 + ((k >> 9) * 8 + (k & 7)) * 16 + e4 * 4) = ((const float4*)p.in[I_RW])[i]; }
  int* lcnt = (int*)(smem + 68 * 1024);
  int* lbase = lcnt + 16;
  int* lrec = lcnt + 32;
  if (TID < 16) lcnt[TID] = 0;
  __syncthreads();
  int iter = 0;
  const int NR = rows_after_mixer(l);
  for (int r = (BID * NTHR + TID) >> 6; r < NR; r += (gridDim.x * NTHR) >> 6, ++iter) {
    const RowInfo q = rinfo(r);
    const float* xin = q.ctx ? ((l == 0 ? p.in[I_CTX] : (const float*)(p.ws + WS_XC)) + (size_t)(r - NLAT) * D)
                             : ((l == 0 ? p.in[I_X] : (const float*)p.out) + (size_t)r * D);
    float* xout = q.ctx ? ((float*)(p.ws + WS_XC) + (size_t)(r - NLAT) * D) : (p.out + (size_t)r * D);
    const float* mod = (const float*)(p.ws + WS_MOD) + (size_t)(l * 5 + modrow(q)) * 6144;
    float y[16], x[16];
    ld16b_nt((const bf16_t*)(p.ws + WS_Y) + (size_t)r * D + k0, y);
    ld16f_nt(xin + k0, x);
    float ss = 0.f;
#pragma unroll
    for (int i = 0; i < 16; ++i) ss += y[i] * y[i];
    ss = wave_sum(ss);
    const float rstd = rsqrtf(ss * (1.f / 1024.f) + EPS);
    {
      float gp[16], gt[16];
      ld16f(p.in[I_MIXPOST] + l * D + k0, gp); ld16f(mod + 2 * 1024 + k0, gt);
#pragma unroll
      for (int i = 0; i < 16; ++i) x[i] += gt[i] * (y[i] * rstd * gp[i]);
    }
    st16f_nt(xout + k0, x);
    float s2 = 0.f;
#pragma unroll
    for (int i = 0; i < 16; ++i) s2 += x[i] * x[i];
    s2 = wave_sum(s2);
    const float rstd2 = rsqrtf(s2 * (1.f / 1024.f) + EPS);
    float h[16];
    {
      float gv[16], sh[16], sc[16];
      ld16f(p.in[I_FFNPRE] + l * D + k0, gv); ld16f(mod + 3 * 1024 + k0, sh); ld16f(mod + 4 * 1024 + k0, sc);
#pragma unroll
      for (int i = 0; i < 16; ++i) h[i] = x[i] * rstd2 * gv[i] * (1.f + sc[i]) + sh[i];
    }
    st16b((bf16_t*)(p.ws + WS_BUFA) + (size_t)r * D + k0, h);
    float lg[16];
#pragma unroll
    for (int e = 0; e < 16; ++e) lg[e] = 0.f;
#pragma unroll
    for (int j = 0; j < 16; ++j) {
      const float4* wrow = (const float4*)(wr + lane * 260 + j * 16);
#pragma unroll
      for (int e4 = 0; e4 < 4; ++e4) { const float4 wv = wrow[e4]; lg[4 * e4] += h[j] * wv.x; lg[4 * e4 + 1] += h[j] * wv.y; lg[4 * e4 + 2] += h[j] * wv.z; lg[4 * e4 + 3] += h[j] * wv.w; }
      if (j & 1) __builtin_amdgcn_sched_barrier(0);
    }
#pragma unroll
    for (int e = 0; e < 16; ++e) lg[e] = wave_sum(lg[e]);
    if (lane == 0) {
      float sc[16], bi[16];
      const float vz = __int_as_float(launder_v(0));
#pragma unroll
      for (int e = 0; e < 16; ++e) { sc[e] = frcp(1.f + __expf(-(lg[e] + vz))); bi[e] = sc[e] + p.in[I_RB][e]; }
      float bgs = -1e30f; int e1 = 0, e2 = 0; float w1 = 0.f, w2 = 0.f;
#pragma unroll
      for (int g = 0; g < 4; ++g) {
        float m1 = -1e30f, m2 = -1e30f, s1v = 0.f, s2v = 0.f; int i1 = 0, i2 = 0;
#pragma unroll
        for (int j = 0; j < 4; ++j) {
          const float v = bi[g * 4 + j], sv = sc[g * 4 + j];
          const bool g1 = v > m1, g2 = v > m2;
          m2 = g1 ? m1 : (g2 ? v : m2); i2 = g1 ? i1 : (g2 ? j : i2); s2v = g1 ? s1v : (g2 ? sv : s2v);
          m1 = g1 ? v : m1; i1 = g1 ? j : i1; s1v = g1 ? sv : s1v;
        }
        const float gs = m1 + m2;
        const bool better = gs > bgs;
        bgs = better ? gs : bgs; e1 = better ? g * 4 + i1 : e1; e2 = better ? g * 4 + i2 : e2; w1 = better ? s1v : w1; w2 = better ? s2v : w2;
      }
      const float inv = frcp(w1 + w2);
      const int li1 = atomicAdd(&lcnt[e1], 1), li2 = atomicAdd(&lcnt[e2], 1);
      int* rec = lrec + ((TID >> 6) * 16 + iter) * 8;
      rec[0] = r; rec[1] = e1; rec[2] = e2; rec[3] = li1; rec[4] = li2; rec[5] = __float_as_int(w1 * inv); rec[6] = __float_as_int(w2 * inv);
    }
  }
  __syncthreads();
  int* CNT = (int*)(p.ws + WS_CTL) + l * 16;
  if (TID < 16) lbase[TID] = atomicAdd(&CNT[TID], lcnt[TID]);
  __syncthreads();
  {
    const int wv = TID >> 4, it = TID & 15;
    int nit = 0;
    for (int r = (BID * NTHR + wv * 64) >> 6; r < NR; r += (gridDim.x * NTHR) >> 6) ++nit;
    if (TID < 128 && it < nit) {
      const int* rec = lrec + (wv * 16 + it) * 8;
      const int r = rec[0], e1 = rec[1], e2 = rec[2];
      const int s1 = lbase[e1] + rec[3], sl2 = lbase[e2] + rec[4];
      int* INV = (int*)(p.ws + WS_INV);
      INV[(size_t)e1 * NT + s1] = r; INV[(size_t)e2 * NT + sl2] = r;
      int* POS = (int*)(p.ws + WS_TOPK); float* GW = (float*)(p.ws + WS_TOPK + (size_t)NT * 8);
      POS[r * 2] = (e1 << 20) | s1; POS[r * 2 + 1] = (e2 << 20) | sl2;
      GW[r * 2] = __int_as_float(rec[5]); GW[r * 2 + 1] = __int_as_float(rec[6]);
    }
  }
  __syncthreads();
}
DI void ph_postffn_v(const PT& p_, int l) {
  const PT p = launder(p_); const int TID = launder_v(threadIdx.x); const int BID = launder_s(blockIdx.x); (void)TID; (void)BID;
  const int lane = TID & 63, k0 = lane * 8;
  const int* CNT = (const int*)(p.ws + WS_CTL) + l * 16;
  const int NR = rows_after_mixer(l);
  for (int r = (BID * NTHR + TID) >> 6; r < NR; r += (gridDim.x * NTHR) >> 6) {
    const RowInfo q = rinfo(r);
    float* xp = q.ctx ? ((float*)(p.ws + WS_XC) + (size_t)(r - NLAT) * D) : (p.out + (size_t)r * D);
    const int* POS = (const int*)(p.ws + WS_TOPK); const float* GW = (const float*)(p.ws + WS_TOPK + (size_t)NT * 8);
    const int p1 = POS[r * 2], p2 = POS[r * 2 + 1];
    const size_t r1 = (size_t)(expert_off(CNT, p1 >> 20) + (p1 & 0xFFFFF)), r2 = (size_t)(expert_off(CNT, p2 >> 20) + (p2 & 0xFFFFF));
    const float w1 = GW[r * 2], w2 = GW[r * 2 + 1];
    float f[16], a[16], b2[16], x[16];
    ld16b_nt((const bf16_t*)(p.ws + WS_FS) + (size_t)r * D + k0, f);
    ld16b_nt((const bf16_t*)(p.ws + WS_R) + r1 * D + k0, a);
    ld16b_nt((const bf16_t*)(p.ws + WS_R) + r2 * D + k0, b2);
    ld16f_nt(xp + k0, x);
    const float* mod = (const float*)(p.ws + WS_MOD) + (size_t)(l * 5 + modrow(q)) * 6144;
    float ss = 0.f;
#pragma unroll
    for (int i = 0; i < 16; ++i) { f[i] += w1 * a[i] + w2 * b2[i]; ss += f[i] * f[i]; }
    ss = wave_sum(ss);
    const float rstd = rsqrtf(ss * (1.f / 1024.f) + EPS);
    {
      float gp[16], gt[16];
      ld16f(p.in[I_FFNPOST] + l * D + k0, gp); ld16f(mod + 5 * 1024 + k0, gt);
#pragma unroll
      for (int i = 0; i < 16; ++i) x[i] += gt[i] * (f[i] * rstd * gp[i]);
    }
    st16f_nt(xp + k0, x);
    if (l + 1 < DEPTH) {
      const float* mod2 = (const float*)(p.ws + WS_MOD) + (size_t)((l + 1) * 5 + modrow(q)) * 6144;
      norm_mod_store(x, p.in[I_MIXPRE] + (l + 1) * D + k0, mod2 + k0, mod2 + 1024 + k0, (bf16_t*)(p.ws + WS_BUFA) + (size_t)r * D + k0);
    }
  }
}
template <int CTRL> DI float dpp_mov_add(float v) { int t = __builtin_amdgcn_update_dpp(0, __float_as_int(v), CTRL, 0xf, 0xf, true); return v + __int_as_float(t); }
DI float sum8_dpp(float v) { v = dpp_mov_add<0xB1>(v); v = dpp_mov_add<0x4E>(v); v = dpp_mov_add<0x141>(v); return v; }
DI void ph_rwkvout_v(const PT& p_, int l) {
  const PT p = launder(p_); const int TID = launder_v(threadIdx.x); const int BID = launder_s(blockIdx.x); (void)TID; (void)BID;
  const int lane = TID & 63, c0 = lane * 8;
  const bf16_t* P = (const bf16_t*)(p.ws + WS_P);
  const bf16_t* AA = (const bf16_t*)(p.ws + WS_AA);
  const bf16_t* YS = (const bf16_t*)(p.ws + WS_BUFA);
  const float* mu = p.in[I_MU] + (size_t)l * 2 * RW_COLS;
  float lg[8], lb[8], rk[8], ka[8];
#pragma unroll
  for (int i = 0; i < 8; ++i) { lg[i] = p.in[I_LNG][l * 512 + c0 + i]; lb[i] = p.in[I_LNB][l * 512 + c0 + i]; rk[i] = p.in[I_RK][l * 512 + c0 + i]; ka[i] = p.in[I_KA][l * 512 + c0 + i]; }
  const int NR = rows_after_mixer(l);
  for (int r = (BID * NTHR + TID) >> 6; r < NR; r += (gridDim.x * NTHR) >> 6) {
    const RowInfo q = rinfo(r);
    float y0[8], y1[8], rr[8], kr[8], vv[8], a0[8], a1[8], gg[8];
    { const uint4 u = ldu4_nt(YS + (size_t)r * 512 + c0); unpack8(u, y0); }
    { const uint4 u = ldu4_nt(YS + (size_t)NT * 512 + (size_t)r * 512 + c0); unpack8(u, y1); }
    ps8(P, mu, r, q, c0, rr); ps8(P, mu, r, q, 512 + c0, kr); ps8(P, mu, r, q, 1024 + c0, vv);
    { const uint4 u = ldu4_nt(AA + ((size_t)r * 2 + 0) * 512 + c0); unpack8(u, a0); }
    { const uint4 u = ldu4_nt(AA + ((size_t)r * 2 + 1) * 512 + c0); unpack8(u, a1); }
    { const uint4 u = ldu4_nt(P + (size_t)r * IN_COLS + gcol(c0)); unpack8(u, gg); }
    float sy = 0.f, sb = 0.f;
#pragma unroll
    for (int i = 0; i < 8; ++i) { y0[i] += y1[i]; sy += y0[i]; const float ke = kr[i] * (2.f + (a0[i] + a1[i] - 2.f) * ka[i]); sb += rr[i] * ke * rk[i]; }
    const float mean = sum8_dpp(sy) * (1.f / 64.f), bonus = sum8_dpp(sb);
    float sv = 0.f;
#pragma unroll
    for (int i = 0; i < 8; ++i) { y0[i] -= mean; sv += y0[i] * y0[i]; }
    const float rs = rsqrtf(sum8_dpp(sv) * (1.f / 64.f) + 64e-5f);
    float o[8];
#pragma unroll
    for (int i = 0; i < 8; ++i) o[i] = (y0[i] * rs * lg[i] + lb[i] + bonus * vv[i]) * gg[i];
    *(uint4*)((bf16_t*)(p.ws + WS_RW) + (size_t)r * 512 + c0) = pack8(o);
  }
}
constexpr size_t WS_G = WS_KN;

DI void ph_mla_lora(const PT& p_, int l, unsigned char* smem) {
  const PT p = launder(p_); const int TID = launder_v(threadIdx.x); const int BID = launder_s(blockIdx.x); (void)TID; (void)BID;
  const bf16_t* P = (const bf16_t*)(p.ws + WS_P);
  constexpr int TM = NT / BM;
  constexpr int T_Q = TM * 6, T_KV = TM * 8, T_LORA = TM * 16;
  const float* mu = p.in[I_MU] + (size_t)l * 2 * RW_COLS;
  for (int t = vblock(BID); t < T_Q + T_KV + T_LORA; t += gridDim.x) {
    if (t < T_Q) {
      int mt, nt; band_tile(t, TM, 6, 4, mt, nt);
      const OpMlaQ op{P, p.in[I_WUQ] + (size_t)l * 256 * 768, p.in[I_QNG] + l * 256, (bf16_t*)(p.ws + WS_Q), mt * BM, nt * BN};
      gemm_tile(op, smem, TID);
    } else if (t < T_Q + T_KV) {
      int mt, nt; band_tile(t - T_Q, TM, 8, 4, mt, nt);
      const OpMlaKV op{P, p.in[I_WUKV] + (size_t)l * 128 * 1024, p.in[I_KVNG] + l * 128, (bf16_t*)(p.ws + WS_KN), (bf16_t*)(p.ws + WS_VT), mt * BM, nt * BN};
      gemm_tile(op, smem, TID);
    } else {
      int mt, v; band_tile(t - T_Q - T_KV, TM, 16, 2, mt, v);
      const int kind = v >> 3, d = (v >> 2) & 1, nt = v & 3;
      const float* W = (kind ? p.in[I_A2] : p.in[I_W2]) + (size_t)(l * 2 + d) * 64 * 512;
      const float* bias = (kind ? p.in[I_A0] : p.in[I_W0]) + (l * 2 + d) * 512;
      const OpLora op{P, mu, W, bias, (bf16_t*)(p.ws + (kind ? WS_AA : WS_DEC)), mt * BM, nt * BN, d, kind};
      gemm_tile(op, smem, TID);
    }
  }
  for (int idx = BID * NTHR + TID; idx < NT * 16; idx += gridDim.x * NTHR) {
    const int r = idx >> 4, i = idx & 15;
    const RowInfo q = rinfo(r);
    const bf16_t* prow = P + (size_t)r * IN_COLS;
    float a1 = bf2f(prow[384 + i]), a2 = bf2f(prow[384 + 16 + i]), o1, o2;
    rope_pair(a1, a2, i, q, o1, o2);
    bf16_t* KR = (bf16_t*)(p.ws + WS_KR) + ((size_t)q.b * KEYS + keyidx(q)) * 32;
    KR[i] = f2bf(o1); KR[16 + i] = f2bf(o2);
  }
}
DI void ph_gate(const PT& p_, int l, unsigned char* smem) {
  const PT p = launder(p_); const int TID = launder_v(threadIdx.x); const int BID = launder_s(blockIdx.x); (void)TID; (void)BID;
  constexpr int TM = NT / BM;
  const float* mu = p.in[I_MU] + (size_t)l * 2 * RW_COLS;
  for (int t = vblock(BID); t < TM * 4; t += gridDim.x) {
    int mt, nt; band_tile(t, TM, 4, 8, mt, nt);
    const OpGate op{(const bf16_t*)(p.ws + WS_P), mu, p.in[I_G2] + (size_t)l * 160 * 512, (bf16_t*)(p.ws + WS_P), mt * BM, nt * BN};
    gemm_tile(op, smem, TID);
  }
}
DI void ph_rwkvout2(const PT& p_, int l) {
  const PT p = launder(p_); const int TID = launder_v(threadIdx.x); const int BID = launder_s(blockIdx.x); (void)TID; (void)BID;
  const int lane = TID & 63;
  const bf16_t* P = (const bf16_t*)(p.ws + WS_P);
  const bf16_t* AA = (const bf16_t*)(p.ws + WS_AA);
  const bf16_t* YS = (const bf16_t*)(p.ws + WS_BUFA);
  const bf16_t* G = (const bf16_t*)(p.ws + WS_G);
  const float* mu = p.in[I_MU] + (size_t)l * 2 * RW_COLS;
  for (int wv = (BID * NTHR + TID) >> 6; wv < NT * 8; wv += (gridDim.x * NTHR) >> 6) {
    const int r = wv >> 3, h = wv & 7, c = h * 64 + lane;
    const RowInfo q = rinfo(r);
    float y = bf2f(YS[(size_t)r * 512 + c]) + bf2f(YS[(size_t)NT * 512 + (size_t)r * 512 + c]);
    float mean = wave_sum(y) * (1.f / 64.f);
    float dv = y - mean;
    float var = wave_sum(dv * dv) * (1.f / 64.f);
    float yn = dv * rsqrtf(var + 64e-5f) * p.in[I_LNG][l * 512 + c] + p.in[I_LNB][l * 512 + c];
    float rr = ps_val(P, mu, r, q, c), kraw = ps_val(P, mu, r, q, 512 + c), vv = ps_val(P, mu, r, q, 1024 + c);
    float ka = p.in[I_KA][l * 512 + c];
    float a0 = bf2f(AA[((size_t)r * 2 + 0) * 512 + c]), a1 = bf2f(AA[((size_t)r * 2 + 1) * 512 + c]);
    float keffsum = kraw * (1.f + (a0 - 1.f) * ka) + kraw * (1.f + (a1 - 1.f) * ka);
    float bonus = wave_sum(rr * keffsum * p.in[I_RK][l * 512 + c]);
    float gg = bf2f(G[(size_t)r * 512 + c]);
    ((bf16_t*)(p.ws + WS_RW))[(size_t)r * 512 + c] = f2bf((yn + bonus * vv) * gg);
  }
}
DI void ph_mod2(const PT& p_, unsigned char* smem) {
  const PT p = launder(p_); const int TID = launder_v(threadIdx.x); const int BID = launder_s(blockIdx.x); (void)TID; (void)BID;
  float* cs = (float*)smem;
  float* red = cs + 5 * 1024;
  for (int i = TID; i < 5 * 1024; i += NTHR) { float v = i < 4096 ? p.in[I_C][i] : p.in[I_CCTX][i - 4096]; cs[i] = v / (1.f + __expf(-v)); }
  __syncthreads();
  float* MOD = (float*)(p.ws + WS_MOD);
  for (int chunk = BID; chunk < DEPTH * 6144 / 48; chunk += gridDim.x) {
    const int gc0 = chunk * 48, l = gc0 / 6144, n0 = gc0 % 6144;
    const float* W = p.in[I_ADAW] + (size_t)l * 1024 * 6144;
    const int c = TID % 48, kg = TID / 48;
    if (kg < 10) {
      float acc[5] = {0.f, 0.f, 0.f, 0.f, 0.f};
#pragma unroll 8
      for (int k = kg; k < 1024; k += 10) {
        const float w = W[(size_t)k * 6144 + n0 + c];
#pragma unroll
        for (int r = 0; r < 5; ++r) acc[r] += cs[r * 1024 + k] * w;
      }
#pragma unroll
      for (int r = 0; r < 5; ++r) red[(kg * 48 + c) * 5 + r] = acc[r];
    }
    __syncthreads();
    if (TID < 240) {
      const int cc = TID / 5, r = TID % 5;
      float a = p.in[I_ADAB][l * 6144 + n0 + cc];
      for (int kg2 = 0; kg2 < 10; ++kg2) a += red[(kg2 * 48 + cc) * 5 + r];
      MOD[(size_t)(l * 5 + r) * 6144 + n0 + cc] = a;
    }
    __syncthreads();
  }
}


constexpr int CS = 16, NCHK = (CTX + SEQ) / CS;
constexpr int S_VEC_SZ = 6 * CS * 64 * 4;
constexpr int S_BB = 2 * S_VEC_SZ;
constexpr int BB_PM = 0, BB_RM = 2048, BB_HP = 4096, BB_VM = 8192, BB_BK = 10240, BB_WC = 14336, BB_SZ = 14592;
constexpr int S_CB = S_BB + 3 * BB_SZ;
constexpr int CB_SZ = 2048;
constexpr int S_CSCR = S_CB + 2 * CB_SZ;
constexpr int SCAN2_LDS = S_CSCR + 2048;
static_assert(SCAN2_LDS <= 110 * 1024, "scan2 lds");

struct SRaw { unsigned pc[3], pv[3], nx[3], aa, dec; };
struct ChunkGeo { int rbase, t0, len, rdir; };
DI ChunkGeo chunk_geo(int b, int d, int chunk) {
  const int st0 = chunk * CS;
  const bool cx = st0 < CTX;
  const int s2 = cx ? st0 : st0 - CTX, L = cx ? CTX : SEQ;
  ChunkGeo q;
  q.t0 = d ? L - 1 - s2 : s2;
  q.rbase = (cx ? NLAT + b * CTX : b * SEQ) + q.t0;
  q.len = L; q.rdir = d ? -1 : 1;
  return q;
}
DI void sa_fetch(const bf16_t* P, const bf16_t* DEC, const bf16_t* AA, const ChunkGeo& q, int h, int d, int sl, int lane, SRaw& raw) {
  const unsigned c0b = (unsigned)(h * 64 + 2 * (lane & 31)) * 2u;
  const int r = q.rbase + q.rdir * sl, t = q.t0 + q.rdir * sl;
  const unsigned rowb = (unsigned)r * (unsigned)(IN_COLS * 2) + (unsigned)(MLA_COLS * 2) + c0b;
  const unsigned prevb = rowb - (t > 0 ? (unsigned)(IN_COLS * 2) : 0u), nextb = rowb + (t < q.len - 1 ? (unsigned)(IN_COLS * 2) : 0u);
  const char* Pb = (const char*)P;
#pragma unroll
  for (int j = 0; j < 3; ++j) {
    raw.pc[j] = *(const unsigned*)(Pb + (size_t)(rowb + (unsigned)(j * 1024)));
    raw.pv[j] = *(const unsigned*)(Pb + (size_t)(prevb + (unsigned)(j * 1024)));
    raw.nx[j] = *(const unsigned*)(Pb + (size_t)(nextb + (unsigned)(j * 1024)));
  }
  const unsigned adb = ((unsigned)r * 2u + (unsigned)d) * 1024u + c0b;
  raw.aa = *(const unsigned*)((const char*)AA + (size_t)adb);
  raw.dec = *(const unsigned*)((const char*)DEC + (size_t)adb);
}
DI void sa_emit(const SRaw& raw, const ScanConst& K, const ChunkGeo& q, int sl, int lane, float* vec) {
  const int half = lane >> 5, l2 = lane & 31;
  const int t = q.t0 + q.rdir * sl;
  const float mp = t > 0 ? 1.f : 0.f, mn = t < q.len - 1 ? 1.f : 0.f;
  float v[3][2];
#pragma unroll
  for (int j = 0; j < 3; ++j) {
    const float c0 = blo(raw.pc[j]), c1 = bhi(raw.pc[j]);
    v[j][0] = c0 + K.m0[j][0] * (mp * blo(raw.pv[j]) - c0) + K.m1[j][0] * (mn * blo(raw.nx[j]) - c0);
    v[j][1] = c1 + K.m0[j][1] * (mp * bhi(raw.pv[j]) - c1) + K.m1[j][1] * (mn * bhi(raw.nx[j]) - c1);
  }
  const float a0 = blo(raw.aa), a1 = bhi(raw.aa);
  const float w0 = 1.f - blo(raw.dec), w1 = 1.f - bhi(raw.dec);
  float k0 = v[1][0] * K.kkw[0], k1 = v[1][1] * K.kkw[1];
  const float ss = sum16_dpp(k0 * k0 + k1 * k1);
  const auto pr = __builtin_amdgcn_permlane16_swap(__float_as_uint(ss), __float_as_uint(ss), false, false);
  const float rn = rsqrtf((__uint_as_float(pr[0]) + __uint_as_float(pr[1])) + 1e-12f);
  k0 *= rn; k1 *= rn;
  float* o = vec + sl * 64 + 2 * l2;
  *(float2*)(o) = make_float2(k0, k1);
  *(float2*)(o + 1 * CS * 64) = make_float2(w0, w1);
  *(float2*)(o + 2 * CS * 64) = make_float2(k0 * a0, k1 * a1);
  *(float2*)(o + 3 * CS * 64) = make_float2(v[1][0] * (1.f + (a0 - 1.f) * K.kaw[0]), v[1][1] * (1.f + (a1 - 1.f) * K.kaw[1]));
  *(float2*)(o + 4 * CS * 64) = make_float2(v[0][0], v[0][1]);
  *(float2*)(o + 5 * CS * 64) = make_float2(v[2][0], v[2][1]);
}
DI void stage_b1(const float* vec, unsigned char* bb, int lane) {
  const int j = lane, jj = j & 31;
  const int slot = (((j >> 5) * 4 + ((jj & 15) >> 2)) * 8) + (jj & 3) + ((jj >> 4) << 2);
  bf16_t* PmP = (bf16_t*)(bb + BB_PM); bf16_t* RmP = (bf16_t*)(bb + BB_RM);
  float Wc = 1.f;
  float ikk[16], iw[16], ir[16];
#pragma unroll
  for (int s = 0; s < 16; ++s) { ikk[s] = vec[(0 * CS + s) * 64 + j]; iw[s] = vec[(1 * CS + s) * 64 + j]; ir[s] = vec[(4 * CS + s) * 64 + j]; }
#pragma unroll
  for (int s = 0; s < 16; ++s) {
    const float pm = Wc * ikk[s];
    Wc *= iw[s];
    const float rm = Wc * ir[s];
    PmP[s * 64 + slot] = f2bf(pm); RmP[s * 64 + slot] = f2bf(rm);
  }
}
DI void stage_b2(const float* vec, unsigned char* bb, int lane) {
  const int j = lane, jj = j & 31;
  const int slot = (((j >> 5) * 4 + ((jj & 15) >> 2)) * 8) + (jj & 3) + ((jj >> 4) << 2);
  bf16_t* HP = (bf16_t*)(bb + BB_HP);
  bf16_t* VmP = (bf16_t*)(bb + BB_VM); bf16_t* BKP = (bf16_t*)(bb + BB_BK); float* WcC = (float*)(bb + BB_WC);
  float Wc = 1.f; float bt[16], kt[16];
  float iw[16], ib[16], ik[16], iv[16];
#pragma unroll
  for (int s = 0; s < 16; ++s) { iw[s] = vec[(1 * CS + s) * 64 + j]; ib[s] = vec[(2 * CS + s) * 64 + j]; ik[s] = vec[(3 * CS + s) * 64 + j]; iv[s] = vec[(5 * CS + s) * 64 + j]; }
  float suf[16];
  suf[15] = 1.f;
#pragma unroll
  for (int s = 14; s >= 0; --s) suf[s] = suf[s + 1] * iw[s + 1];
#pragma unroll
  for (int s = 0; s < 16; ++s) Wc *= iw[s];
  const float invT = __builtin_amdgcn_rcpf(Wc);
#pragma unroll
  for (int s = 0; s < 16; ++s) {
    const float inv = invT * suf[s];
    bt[s] = ib[s] * inv; kt[s] = ik[s] * inv;
    BKP[s * 64 + slot] = f2bf(bt[s]); BKP[(16 + s) * 64 + slot] = f2bf(kt[s]);
  }
  WcC[j] = Wc;
#pragma unroll
  for (int g = 0; g < 4; ++g) {
    uint4 o;
    o.x = pack2(-bt[4 * g] * Wc, -bt[4 * g + 1] * Wc); o.y = pack2(-bt[4 * g + 2] * Wc, -bt[4 * g + 3] * Wc);
    o.z = pack2(kt[4 * g] * Wc, kt[4 * g + 1] * Wc);   o.w = pack2(kt[4 * g + 2] * Wc, kt[4 * g + 3] * Wc);
    *(uint4*)(HP + j * 32 + g * 8) = o;
    uint2 vq;
    vq.x = pack2(iv[4 * g], iv[4 * g + 1]); vq.y = pack2(iv[4 * g + 2], iv[4 * g + 3]);
    *(uint2*)(VmP + (((j >> 4) * 4 + g) * 16 + (j & 15)) * 4) = vq;
  }
}
DI void stage_c(const unsigned char* bb, unsigned char* cb, float* scr, int lane) {
  (void)scr;
  const int l15 = lane & 15, g = lane >> 4;
  const bf16_t* PmP = (const bf16_t*)(bb + BB_PM); const bf16_t* RmP = (const bf16_t*)(bb + BB_RM); const bf16_t* BKP = (const bf16_t*)(bb + BB_BK);
  bf16_t* G1P = (bf16_t*)cb; bf16_t* G2P = G1P + 16 * 32;
  const f32x4 z4 = {0.f, 0.f, 0.f, 0.f};
  f32x4 oPB = z4, oPK = z4, oRB = z4, oRK = z4, oBP = z4;
#pragma unroll
  for (int ks = 0; ks < 2; ++ks) {
    const bf16x8 aP = *(const bf16x8*)(PmP + l15 * 64 + (ks * 4 + g) * 8), aR = *(const bf16x8*)(RmP + l15 * 64 + (ks * 4 + g) * 8);
    const bf16x8 bB = *(const bf16x8*)(BKP + l15 * 64 + (ks * 4 + g) * 8), bK = *(const bf16x8*)(BKP + (16 + l15) * 64 + (ks * 4 + g) * 8);
    oPB = __builtin_amdgcn_mfma_f32_16x16x32_bf16(aP, bB, oPB, 0, 0, 0); oBP = __builtin_amdgcn_mfma_f32_16x16x32_bf16(bB, aP, oBP, 0, 0, 0);
    oPK = __builtin_amdgcn_mfma_f32_16x16x32_bf16(aP, bK, oPK, 0, 0, 0);
    oRB = __builtin_amdgcn_mfma_f32_16x16x32_bf16(aR, bB, oRB, 0, 0, 0); oRK = __builtin_amdgcn_mfma_f32_16x16x32_bf16(aR, bK, oRK, 0, 0, 0);
  }
  f32x4 nC, nT, XT, XB;
#pragma unroll
  for (int r = 0; r < 4; ++r) {
    const int sI = 4 * g + r;
    nC[r] = l15 < sI ? -oPB[r] : 0.f;
    nT[r] = sI < l15 ? -oBP[r] : 0.f;
    XT[r] = ((sI == l15) ? 1.f : 0.f) + nC[r];
    XB[r] = l15 < sI ? oPK[r] : 0.f;
    G2P[sI * 32 + (l15 >> 2) * 8 + (l15 & 3)] = f2bf(l15 <= sI ? -oRB[r] : 0.f);
    G2P[sI * 32 + (l15 >> 2) * 8 + 4 + (l15 & 3)] = f2bf(l15 <= sI ? oRK[r] : 0.f);
  }
#define PK4(v) __builtin_bit_cast(bf16x8, make_uint4(pack2((v)[0], (v)[1]), pack2((v)[2], (v)[3]), 0u, 0u))
  const bf16x8 a1 = PK4(nT), a1t = PK4(nC);
  XB = __builtin_amdgcn_mfma_f32_16x16x32_bf16(a1, PK4(XB), XB, 0, 0, 0);
  const f32x4 p2 = __builtin_amdgcn_mfma_f32_16x16x32_bf16(a1, a1t, z4, 0, 0, 0), q2 = __builtin_amdgcn_mfma_f32_16x16x32_bf16(a1t, a1, z4, 0, 0, 0);
  const bf16x8 a2 = PK4(q2), a2t = PK4(p2);
  XT = __builtin_amdgcn_mfma_f32_16x16x32_bf16(a2, PK4(XT), XT, 0, 0, 0);
  XB = __builtin_amdgcn_mfma_f32_16x16x32_bf16(a2, PK4(XB), XB, 0, 0, 0);
  const f32x4 p4 = __builtin_amdgcn_mfma_f32_16x16x32_bf16(a2, a2t, z4, 0, 0, 0), q4 = __builtin_amdgcn_mfma_f32_16x16x32_bf16(a2t, a2, z4, 0, 0, 0);
  const bf16x8 a4 = PK4(q4), a4t = PK4(p4);
  XT = __builtin_amdgcn_mfma_f32_16x16x32_bf16(a4, PK4(XT), XT, 0, 0, 0);
  XB = __builtin_amdgcn_mfma_f32_16x16x32_bf16(a4, PK4(XB), XB, 0, 0, 0);
  const f32x4 q8 = __builtin_amdgcn_mfma_f32_16x16x32_bf16(a4t, a4, z4, 0, 0, 0);
  const bf16x8 a8 = PK4(q8);
  XT = __builtin_amdgcn_mfma_f32_16x16x32_bf16(a8, PK4(XT), XT, 0, 0, 0);
  XB = __builtin_amdgcn_mfma_f32_16x16x32_bf16(a8, PK4(XB), XB, 0, 0, 0);
#undef PK4
#pragma unroll
  for (int r = 0; r < 4; ++r) {
    const int u = 4 * g + r;
    G1P[u * 32 + (l15 >> 2) * 8 + (l15 & 3)] = f2bf(XT[r]);
    G1P[u * 32 + (l15 >> 2) * 8 + 4 + (l15 & 3)] = f2bf(XB[r]);
  }
}
DI void scan_consume(f32x4 (&st)[4], const unsigned char* smem, bf16_t* YS, int i, int b, int d, int w, int l15, int g) {
  const unsigned char* bb = smem + S_BB + (i % 3) * BB_SZ;
  const unsigned char* cbuf = smem + S_CB + (i & 1) * CB_SZ;
  const bf16_t* PmP = (const bf16_t*)(bb + BB_PM); const bf16_t* RmP = (const bf16_t*)(bb + BB_RM); const bf16_t* HP = (const bf16_t*)(bb + BB_HP);
  const bf16_t* VmP = (const bf16_t*)(bb + BB_VM); const float* WcC = (const float*)(bb + BB_WC);
  const bf16_t* G1P = (const bf16_t*)cbuf; const bf16_t* G2P = G1P + 16 * 32;
  f32x4 d1 = {0.f, 0.f, 0.f, 0.f}, d2 = d1;
#pragma unroll
  for (int ks = 0; ks < 2; ++ks) {
    uint4 sp;
    sp.x = pack2(st[2 * ks][0], st[2 * ks][1]); sp.y = pack2(st[2 * ks][2], st[2 * ks][3]);
    sp.z = pack2(st[2 * ks + 1][0], st[2 * ks + 1][1]); sp.w = pack2(st[2 * ks + 1][2], st[2 * ks + 1][3]);
    const bf16x8 sf = __builtin_bit_cast(bf16x8, sp);
    const bf16x8 aP = *(const bf16x8*)(PmP + l15 * 64 + (ks * 4 + g) * 8), aR = *(const bf16x8*)(RmP + l15 * 64 + (ks * 4 + g) * 8);
    d1 = __builtin_amdgcn_mfma_f32_16x16x32_bf16(aP, sf, d1, 0, 0, 0);
    d2 = __builtin_amdgcn_mfma_f32_16x16x32_bf16(aR, sf, d2, 0, 0, 0);
  }
  const uint2 vm = *(const uint2*)(VmP + ((w * 4 + g) * 16 + l15) * 4);
  uint4 ep; ep.x = pack2(d1[0], d1[1]); ep.y = pack2(d1[2], d1[3]); ep.z = vm.x; ep.w = vm.y;
  const bf16x8 g1 = *(const bf16x8*)(G1P + l15 * 32 + g * 8);
  const f32x4 zero4 = {0.f, 0.f, 0.f, 0.f};
  const f32x4 skt = __builtin_amdgcn_mfma_f32_16x16x32_bf16(g1, __builtin_bit_cast(bf16x8, ep), zero4, 0, 0, 0);
  uint4 fp; fp.x = pack2(skt[0], skt[1]); fp.y = pack2(skt[2], skt[3]); fp.z = vm.x; fp.w = vm.y;
  const bf16x8 ff = __builtin_bit_cast(bf16x8, fp);
  const bf16x8 g2 = *(const bf16x8*)(G2P + l15 * 32 + g * 8);
  const f32x4 yt = __builtin_amdgcn_mfma_f32_16x16x32_bf16(g2, ff, d2, 0, 0, 0);
#pragma unroll
  for (int r = 0; r < 4; ++r) YS[(size_t)scan_row(b, d, i * CS + 4 * g + r) * 512] = f2bf(yt[r]);
#pragma unroll
  for (int jt = 0; jt < 4; ++jt) {
    const float4 wc = *(const float4*)(WcC + 16 * jt + 4 * g);
    f32x4 sc = st[jt];
    sc[0] *= wc.x; sc[1] *= wc.y; sc[2] *= wc.z; sc[3] *= wc.w;
    const bf16x8 hf = *(const bf16x8*)(HP + (jt * 16 + l15) * 32 + g * 8);
    st[jt] = __builtin_amdgcn_mfma_f32_16x16x32_bf16(hf, ff, sc, 0, 0, 0);
  }
}
DI void ph_scan2(const PT& p, int l, unsigned char* smem, const int TID, const int job, const int xmode) {
  const int lane = TID & 63, w = TID >> 6, l15 = lane & 15, g = lane >> 4;
  const int d = job & 1, h = (job >> 1) & 7, b = job >> 4;
  float* vecb = (float*)smem;
  const bf16_t* P = (const bf16_t*)(p.ws + WS_P);
  const bf16_t* DEC = (const bf16_t*)(p.ws + WS_DEC);
  const bf16_t* AA = (const bf16_t*)(p.ws + WS_AA);
  const int half = lane >> 5;
#define SA_CONST() ScanConst K; { const int c0 = h * 64 + 2 * (lane & 31); const float* mu = p.in[I_MU] + (size_t)l * 2 * RW_COLS; \
      _Pragma("unroll") for (int j = 0; j < 3; ++j) _Pragma("unroll") for (int e = 0; e < 2; ++e) { K.m0[j][e] = mu[j * 512 + c0 + e]; K.m1[j][e] = mu[RW_COLS + j * 512 + c0 + e]; } \
      _Pragma("unroll") for (int e = 0; e < 2; ++e) { K.kkw[e] = p.in[I_KK][l * 512 + c0 + e]; K.kaw[e] = p.in[I_KA][l * 512 + c0 + e]; } }
#define SA_FETCH(SET, NU, SB, chunk) do { const ChunkGeo cg_ = chunk_geo(b, d, (xmode & 2) ? 5 : min((chunk), NCHK - 1)); _Pragma("unroll") for (int u = 0; u < NU; ++u) sa_fetch(P, DEC, AA, cg_, h, d, (SB) + 2 * u + half, lane, SET[u]); } while (0)
#define SA_EMIT(SET, NU, SB, chunk) do { float* vec_ = vecb + ((chunk) & 1) * (S_VEC_SZ / 4); const ChunkGeo cg_ = chunk_geo(b, d, min((chunk), NCHK - 1));   \
      _Pragma("unroll") for (int u = 0; u < NU; ++u) sa_emit(SET[u], K, cg_, (SB) + 2 * u + half, lane, vec_); } while (0)
  if (w < 4) {
    bf16_t* YS = (bf16_t*)(p.ws + WS_BUFA) + (size_t)d * NT * 512 + h * 64 + w * 16 + l15;
    SA_CONST();
    const int sbase = 2 * w;
    SRaw r0[1], r1[1];
    SA_FETCH(r0, 1, sbase, 0);
    __builtin_amdgcn_sched_barrier(0);
    SA_FETCH(r1, 1, sbase, 1);
    __builtin_amdgcn_sched_barrier(0);
    f32x4 st[4];
#pragma unroll
    for (int jt = 0; jt < 4; ++jt) st[jt] = (f32x4){0.f, 0.f, 0.f, 0.f};
    auto cons_step = [&](const int i, const bool store) {
        const unsigned char* bb = smem + S_BB + (i % 3) * BB_SZ;
        const unsigned char* cbuf = smem + S_CB + (i & 1) * CB_SZ;
        const bf16_t* PmP = (const bf16_t*)(bb + BB_PM); const bf16_t* RmP = (const bf16_t*)(bb + BB_RM); const bf16_t* HP = (const bf16_t*)(bb + BB_HP);
        const bf16_t* VmP = (const bf16_t*)(bb + BB_VM); const float* WcC = (const float*)(bb + BB_WC);
        const bf16_t* G1P = (const bf16_t*)cbuf; const bf16_t* G2P = G1P + 16 * 32;
        const bf16x8 aP0 = *(const bf16x8*)(PmP + l15 * 64 + g * 8), aR0 = *(const bf16x8*)(RmP + l15 * 64 + g * 8);
        const bf16x8 aP1 = *(const bf16x8*)(PmP + l15 * 64 + (4 + g) * 8), aR1 = *(const bf16x8*)(RmP + l15 * 64 + (4 + g) * 8);
        const uint2 vm = *(const uint2*)(VmP + ((w * 4 + g) * 16 + l15) * 4);
        const bf16x8 g1 = *(const bf16x8*)(G1P + l15 * 32 + g * 8);
        const bf16x8 g2 = *(const bf16x8*)(G2P + l15 * 32 + g * 8);
        float4 wc[4]; bf16x8 hf[4];
#pragma unroll
        for (int jt = 0; jt < 4; ++jt) { wc[jt] = *(const float4*)(WcC + 16 * jt + 4 * g); hf[jt] = *(const bf16x8*)(HP + (jt * 16 + l15) * 32 + g * 8); }
        __builtin_amdgcn_sched_barrier(0);
        f32x4 d1 = {0.f, 0.f, 0.f, 0.f}, d2 = d1;
        {
          uint4 sp;
          sp.x = pack2(st[0][0], st[0][1]); sp.y = pack2(st[0][2], st[0][3]); sp.z = pack2(st[1][0], st[1][1]); sp.w = pack2(st[1][2], st[1][3]);
          const bf16x8 sf = __builtin_bit_cast(bf16x8, sp);
          d1 = __builtin_amdgcn_mfma_f32_16x16x32_bf16(aP0, sf, d1, 0, 0, 0);
          d2 = __builtin_amdgcn_mfma_f32_16x16x32_bf16(aR0, sf, d2, 0, 0, 0);
          sp.x = pack2(st[2][0], st[2][1]); sp.y = pack2(st[2][2], st[2][3]); sp.z = pack2(st[3][0], st[3][1]); sp.w = pack2(st[3][2], st[3][3]);
          const bf16x8 sg = __builtin_bit_cast(bf16x8, sp);
          d1 = __builtin_amdgcn_mfma_f32_16x16x32_bf16(aP1, sg, d1, 0, 0, 0);
          d2 = __builtin_amdgcn_mfma_f32_16x16x32_bf16(aR1, sg, d2, 0, 0, 0);
        }
        uint4 ep; ep.x = pack2(d1[0], d1[1]); ep.y = pack2(d1[2], d1[3]); ep.z = vm.x; ep.w = vm.y;
        const f32x4 zero4 = {0.f, 0.f, 0.f, 0.f};
        const f32x4 skt = __builtin_amdgcn_mfma_f32_16x16x32_bf16(g1, __builtin_bit_cast(bf16x8, ep), zero4, 0, 0, 0);
        uint4 fp; fp.x = pack2(skt[0], skt[1]); fp.y = pack2(skt[2], skt[3]); fp.z = vm.x; fp.w = vm.y;
        const bf16x8 ff = __builtin_bit_cast(bf16x8, fp);
        const f32x4 yt = __builtin_amdgcn_mfma_f32_16x16x32_bf16(g2, ff, d2, 0, 0, 0);
#pragma unroll
        for (int jt = 0; jt < 4; ++jt) {
          f32x4 sc = st[jt];
          sc[0] *= wc[jt].x; sc[1] *= wc[jt].y; sc[2] *= wc[jt].z; sc[3] *= wc[jt].w;
          st[jt] = __builtin_amdgcn_mfma_f32_16x16x32_bf16(hf[jt], ff, sc, 0, 0, 0);
        }
        if (store) {
          const ChunkGeo q = chunk_geo(b, d, i);
          bf16_t* yp = YS + (ptrdiff_t)(q.rbase + q.rdir * 4 * g) * 512;
          const ptrdiff_t ystep = (ptrdiff_t)q.rdir * 512;
#pragma unroll
          for (int r = 0; r < 4; ++r) yp[r * ystep] = f2bf(yt[r]);
        }
    };
    SA_EMIT(r0, 1, sbase, 0); SA_FETCH(r0, 1, sbase, 2); __syncthreads();
    SA_EMIT(r1, 1, sbase, 1); SA_FETCH(r1, 1, sbase, 3); __syncthreads();
    SA_EMIT(r0, 1, sbase, 2); SA_FETCH(r0, 1, sbase, 4); __syncthreads();
#pragma nounroll
    for (int i = 0; i < NCHK; i += 2) {
      cons_step(i, !(xmode & 1));
      SA_EMIT(r1, 1, sbase, i + 3); SA_FETCH(r1, 1, sbase, i + 5);
      __syncthreads();
      cons_step(i + 1, !(xmode & 1));
      SA_EMIT(r0, 1, sbase, i + 4); SA_FETCH(r0, 1, sbase, i + 6);
      __syncthreads();
    }
#if SCX >= 0
    for (int it = 0; it < NCHK; ++it) {
      const int cdm_ = launder_s(NCHK - 1);
      if (SCX == 5 || SCX == 7) cons_step(cdm_, false);
      if (SCX == 5 || SCX == 6 || SCX == 7) { SA_EMIT(r0, 1, sbase, cdm_); SA_FETCH(r0, 1, sbase, cdm_); }
      __syncthreads();
    }
#endif
  } else if (w == 4) {
    SA_CONST();
    SRaw r0[3];
    SA_FETCH(r0, 3, 8, 0);
#pragma nounroll
    for (int ce = 0; ce < NCHK + 3; ++ce) {
      SA_EMIT(r0, 3, 8, ce); SA_FETCH(r0, 3, 8, ce + 1);
      __syncthreads();
    }
#if SCX >= 0
    for (int it = 0; it < NCHK; ++it) { __syncthreads(); }
#endif
  } else if (w == 6) {
    for (int i = -3; i < NCHK; ++i) {
      const int cbk = i + 2;
      if (cbk >= 0 && cbk < NCHK) stage_b2(vecb + (cbk & 1) * (S_VEC_SZ / 4), smem + S_BB + (cbk % 3) * BB_SZ, lane);
      __syncthreads();
    }
#if SCX >= 0
    for (int it = 0; it < NCHK; ++it) {
      const int cdm_ = launder_s(NCHK - 1);
      if (SCX == 3 || SCX == 7) stage_b2(vecb + (cdm_ & 1) * (S_VEC_SZ / 4), smem + S_BB + (cdm_ % 3) * BB_SZ, lane);
      __syncthreads();
    }
#endif
  } else if (w == 5) {
    for (int i = -3; i < NCHK; ++i) {
      const int cbk = i + 2;
      if (cbk >= 0 && cbk < NCHK) stage_b1(vecb + (cbk & 1) * (S_VEC_SZ / 4), smem + S_BB + (cbk % 3) * BB_SZ, lane);
      __syncthreads();
    }
  } else {
    SA_CONST();
    const int sbase = 14;
    SRaw r0[1], r1[1];
    SA_FETCH(r0, 1, sbase, 0);
    __builtin_amdgcn_sched_barrier(0);
    SA_FETCH(r1, 1, sbase, 1);
    __builtin_amdgcn_sched_barrier(0);
#define SB_RUN(ce_) do { const int cc_ = (ce_) - 2; stage_c(smem + S_BB + (cc_ % 3) * BB_SZ, smem + S_CB + (cc_ & 1) * CB_SZ, (float*)(smem + S_CSCR), lane); } while (0)
    SA_EMIT(r0, 1, sbase, 0); SA_FETCH(r0, 1, sbase, 2); __syncthreads();
    SA_EMIT(r1, 1, sbase, 1); SA_FETCH(r1, 1, sbase, 3); __syncthreads();
    SB_RUN(2); SA_EMIT(r0, 1, sbase, 2); SA_FETCH(r0, 1, sbase, 4); __syncthreads();
#pragma nounroll
    for (int ce = 3; ce < NCHK + 3; ce += 2) {
      SB_RUN(ce);
      SA_EMIT(r1, 1, sbase, ce); SA_FETCH(r1, 1, sbase, ce + 2);
      __syncthreads();
      SB_RUN(ce + 1);
      SA_EMIT(r0, 1, sbase, ce + 1); SA_FETCH(r0, 1, sbase, ce + 3);
      __syncthreads();
    }
#undef SB_RUN
  }
#undef SA_FETCH
#undef SA_EMIT
#undef SA_CONST
}
constexpr int ATT2_BUF = (12 + 8) * 64 * 8;
DI void attn_item2(const PT& p, unsigned char* smem, const int TID, int b, int h, int qrow0, int key0, int nkt) {
  bf16_t* base = (bf16_t*)smem;
  const int lane = TID & 63, w = TID >> 6, l15 = lane & 15, g = lane >> 4;
  bf16_t* Qg = (bf16_t*)(p.ws + WS_Q);
  const bf16_t* KN = (const bf16_t*)(p.ws + WS_KN);
  const bf16_t* KR = (const bf16_t*)(p.ws + WS_KR);
  const bf16_t* VT = (const bf16_t*)(p.ws + WS_VT) + (size_t)(b * 8 + h) * 64 * KEYS;
  bf16x8 qf[2][3];
#pragma unroll
  for (int qt = 0; qt < 2; ++qt)
#pragma unroll
    for (int ks = 0; ks < 3; ++ks) qf[qt][ks] = *(const bf16x8*)(Qg + (size_t)(qrow0 + w * 32 + qt * 16 + l15) * 768 + h * 96 + ks * 32 + g * 8);
  f32x4 oacc[4][2];
#pragma unroll
  for (int i = 0; i < 4; ++i)
#pragma unroll
    for (int j = 0; j < 2; ++j) oacc[i][j] = (f32x4){0.f, 0.f, 0.f, 0.f};
  float mrun[2] = {-1e30f, -1e30f}, lsum[2] = {0.f, 0.f};
  const int skey = TID & 63, sc8 = TID >> 6;
  const int lrow = (skey & ~31) | (((skey >> 2) & 1) << 4) | (((skey >> 3) & 3) << 2) | (skey & 3);
  const int rc = (TID >> 6) & 3;
  uint4 r_kn, r_kr, r_vt;
  r_kr = make_uint4(0u, 0u, 0u, 0u);
  {
    const size_t kr0 = (size_t)b * KEYS + key0;
    r_kn = *(const uint4*)(KN + ((kr0 + skey) * 8 + h) * 64 + sc8 * 8);
    if (TID < 256) r_kr = *(const uint4*)(KR + (kr0 + skey) * 32 + rc * 8);
    r_vt = *(const uint4*)(VT + (size_t)skey * KEYS + key0 + sc8 * 8);
    bf16_t* Ks = base; bf16_t* Vs = base + 12 * 64 * 8;
    *(uint4*)(Ks + (sc8 * 64 + lrow) * 8) = r_kn;
    if (TID < 256) *(uint4*)(Ks + ((8 + rc) * 64 + lrow) * 8) = r_kr;
    *(uint4*)(Vs + (sc8 * 64 + skey) * 8) = r_vt;
  }
  __syncthreads();
  for (int t = 0; t < nkt; ++t) {
    const bf16_t* Ks = base + (t & 1) * ATT2_BUF; const bf16_t* Vs = Ks + 12 * 64 * 8;
    const bool more = (t + 1 < nkt);
    if (more) {
      const int k0 = key0 + (t + 1) * 64;
      const size_t kr0 = (size_t)b * KEYS + k0;
      r_kn = *(const uint4*)(KN + ((kr0 + skey) * 8 + h) * 64 + sc8 * 8);
      if (TID < 256) r_kr = *(const uint4*)(KR + (kr0 + skey) * 32 + rc * 8);
      r_vt = *(const uint4*)(VT + (size_t)skey * KEYS + k0 + sc8 * 8);
    }
    f32x4 sacc[4][2];
    float mnq[2];
#define AT_QK(qt) do { \
      _Pragma("unroll") for (int i = 0; i < 4; ++i) sacc[i][qt] = (f32x4){0.f, 0.f, 0.f, 0.f}; \
      _Pragma("unroll") for (int ks = 0; ks < 3; ++ks) _Pragma("unroll") for (int kt = 0; kt < 4; ++kt) { \
        const bf16x8 kf = *(const bf16x8*)(Ks + ((ks * 4 + g) * 64 + kt * 16 + l15) * 8); \
        sacc[kt][qt] = __builtin_amdgcn_mfma_f32_16x16x32_bf16(kf, qf[qt][ks], sacc[kt][qt], 0, 0, 0); } } while (0)
#define AT_MAX(qt) do { \
      float mx = sacc[0][qt][0]; \
      _Pragma("unroll") for (int kt = 0; kt < 4; ++kt) _Pragma("unroll") for (int r = 0; r < 4; ++r) mx = fmaxf(mx, sacc[kt][qt][r]); \
      mx = fmaxf(mx, __shfl_xor(mx, 16)); mx = fmaxf(mx, __shfl_xor(mx, 32)); \
      const float mn = fmaxf(mrun[qt], mx * LOG2E); \
      if (__any(mn > mrun[qt])) { const float alpha = __builtin_amdgcn_exp2f(mrun[qt] - mn); lsum[qt] *= alpha; \
        _Pragma("unroll") for (int vt = 0; vt < 4; ++vt) oacc[vt][qt] *= alpha; } \
      mrun[qt] = mn; mnq[qt] = mn; } while (0)
#define AT_EXP(qt) do { float ls = lsum[qt]; \
      _Pragma("unroll") for (int kt = 0; kt < 4; ++kt) _Pragma("unroll") for (int r = 0; r < 4; ++r) { float pv = __builtin_amdgcn_exp2f(sacc[kt][qt][r] * LOG2E - mnq[qt]); ls += pv; sacc[kt][qt][r] = pv; } \
      lsum[qt] = ls; } while (0)
#define AT_PV(qt) do { \
      _Pragma("unroll") for (int s2 = 0; s2 < 2; ++s2) { \
        uint4 pk; \
        pk.x = pack2(sacc[2 * s2][qt][0], sacc[2 * s2][qt][1]); pk.y = pack2(sacc[2 * s2][qt][2], sacc[2 * s2][qt][3]); \
        pk.z = pack2(sacc[2 * s2 + 1][qt][0], sacc[2 * s2 + 1][qt][1]); pk.w = pack2(sacc[2 * s2 + 1][qt][2], sacc[2 * s2 + 1][qt][3]); \
        const bf16x8 pf = __builtin_bit_cast(bf16x8, pk); \
        _Pragma("unroll") for (int vt = 0; vt < 4; ++vt) { \
          const bf16x8 vf = *(const bf16x8*)(Vs + ((s2 * 4 + g) * 64 + vt * 16 + l15) * 8); \
          oacc[vt][qt] = __builtin_amdgcn_mfma_f32_16x16x32_bf16(vf, pf, oacc[vt][qt], 0, 0, 0); } } } while (0)
    {
      _Pragma("unroll") for (int i = 0; i < 4; ++i) { sacc[i][0] = (f32x4){0.f, 0.f, 0.f, 0.f}; sacc[i][1] = (f32x4){0.f, 0.f, 0.f, 0.f}; }
      _Pragma("unroll") for (int ks = 0; ks < 3; ++ks) _Pragma("unroll") for (int kt = 0; kt < 4; ++kt) {
        const bf16x8 kf = *(const bf16x8*)(Ks + ((ks * 4 + g) * 64 + kt * 16 + l15) * 8);
        sacc[kt][0] = __builtin_amdgcn_mfma_f32_16x16x32_bf16(kf, qf[0][ks], sacc[kt][0], 0, 0, 0);
        sacc[kt][1] = __builtin_amdgcn_mfma_f32_16x16x32_bf16(kf, qf[1][ks], sacc[kt][1], 0, 0, 0);
      }
    }
    AT_MAX(0);
    AT_EXP(0);
    AT_MAX(1);
    AT_PV(0); AT_EXP(1);
    AT_PV(1);
#undef AT_QK
#undef AT_MAX
#undef AT_EXP
#undef AT_PV
    if (more) {
      bf16_t* Ks2 = base + ((t + 1) & 1) * ATT2_BUF; bf16_t* Vs2 = Ks2 + 12 * 64 * 8;
      *(uint4*)(Ks2 + (sc8 * 64 + lrow) * 8) = r_kn;
      if (TID < 256) *(uint4*)(Ks2 + ((8 + rc) * 64 + lrow) * 8) = r_kr;
      *(uint4*)(Vs2 + (sc8 * 64 + skey) * 8) = r_vt;
    }
    __syncthreads();
  }
#pragma unroll
  for (int qt = 0; qt < 2; ++qt) {
    float lq = lsum[qt];
    lq += __shfl_xor(lq, 16); lq += __shfl_xor(lq, 32);
    const float inv = 1.f / lq;
    bf16_t* orow = Qg + (size_t)(qrow0 + w * 32 + qt * 16 + l15) * 768 + h * 96;
#pragma unroll
    for (int vt = 0; vt < 4; ++vt) {
      uint2 o2; o2.x = pack2(oacc[vt][qt][0] * inv, oacc[vt][qt][1] * inv); o2.y = pack2(oacc[vt][qt][2] * inv, oacc[vt][qt][3] * inv);
      *(uint2*)(orow + vt * 16 + 4 * g) = o2;
    }
  }
}
__shared__ int s_item;
DI void ph_p4_scan(const PT& p_, int l, unsigned char* smem) {
  const PT p = launder(p_); const int TID = launder_v(threadIdx.x); const int BID = launder_s(blockIdx.x); (void)TID; (void)BID;
  if (BID < 64) { ph_scan2(p, l, smem, TID, BID, launder_s(0)); if (SCX == -2) { __syncthreads(); ph_scan2(p, l, smem, launder_v(TID), launder_s(BID), launder_s(XM)); } }
}
DI void ph_p4_queue(const PT& p_, int l, unsigned char* smem) {
  const PT p = launder(p_); const int TID = launder_v(threadIdx.x); const int BID = launder_s(blockIdx.x); (void)TID; (void)BID;
  int* QC = (int*)(p.ws + WS_CTL) + 64 + l;
  const int TM = rows_after_mixer(l) / BM, N_ATT = 512 + ((l + 1 < DEPTH) ? 32 : 0), N_GATE = TM * 4;
  const float* mu = p.in[I_MU] + (size_t)l * 2 * RW_COLS;
  for (;;) {
    __syncthreads();
    if (TID == 0) s_item = atomicAdd(QC, 1);
    __syncthreads();
    const int item = s_item;
    if (item >= N_ATT + N_GATE) break;
    if (item < N_ATT) {
      const bool lat = item < 512;
      const int bh = lat ? (item & 31) : (item - 512), qb = item >> 5;
      const int b = bh >> 3, h = bh & 7;
      attn_item2(p, smem, TID, b, h, lat ? b * SEQ + qb * 256 : NLAT + b * CTX, lat ? 0 : SEQ, lat ? KEYS / 64 : CTX / 64);
    } else {
      int mt, nt; band_tile(item - N_ATT, TM, 4, 8, mt, nt);
      const OpGate op{(const bf16_t*)(p.ws + WS_P), mu, p.in[I_G2] + (size_t)l * 160 * 512, (bf16_t*)(p.ws + WS_P), mt * BM, nt * BN};
      gemm_tile(op, smem, TID);
    }
  }
}
#define XB_TMO      128
#define XB_XCNT(j)  (256  + 64 * (j))
#define XB_XSUB(j)  (1280 + 64 * (j))
#define XB_XGEN(j)  (2304 + 64 * (j))
#define XB_TOP      3328
#define XB_TOPGEN   3392
#define XCD_BAR_WORDS 3456
#define XB_SPIN_CAP (1u << 22)
#define LAS __attribute__((address_space(3)))
DI unsigned xb_ld(unsigned* p)              { return __hip_atomic_load(p, __ATOMIC_RELAXED, __HIP_MEMORY_SCOPE_AGENT); }
DI unsigned xb_add(unsigned* p, unsigned v) { return __hip_atomic_fetch_add(p, v, __ATOMIC_RELAXED, __HIP_MEMORY_SCOPE_AGENT); }
DI unsigned xb_xcc_id() { return (unsigned)__builtin_amdgcn_s_getreg((3 << 11) | 20) & 0xFu; }
#define XB_SPIN(cond, bar) do { unsigned _sp = 0; while (cond) { __builtin_amdgcn_s_sleep(1); \
    if ((++_sp & 255u) == 0u) { if (xb_ld(&(bar)[XB_TMO])) break; if (_sp > XB_SPIN_CAP) { atomicAdd(&(bar)[XB_TMO], 1u); break; } } } } while (0)
struct XcdBarrier { unsigned* bar; unsigned x; volatile LAS unsigned* st; };
DI XcdBarrier xcd_barrier_post(unsigned* bar, volatile LAS unsigned* st) {
  XcdBarrier b; b.bar = bar; b.x = xb_xcc_id(); b.st = st;
  if (threadIdx.x == 0) (void)xb_add(&bar[XB_XCNT(b.x)], 1u);
  return b;
}
DI void xcd_barrier_complete(unsigned* bar, unsigned x, unsigned& nloc, unsigned& nx) {
  const unsigned G = gridDim.x * gridDim.y * gridDim.z;
  unsigned sum, cnt, mine, sp = 0u;
  for (;;) {
    sum = 0u; cnt = 0u; mine = 0u;
#pragma unroll
    for (unsigned j = 0; j < 16; ++j) { const unsigned c = xb_ld(&bar[XB_XCNT(j)]); sum += c; cnt += (c > 0u) ? 1u : 0u; mine = (j == x) ? c : mine; }
    if (sum == G) break;
    __builtin_amdgcn_s_sleep(1);
    if ((++sp & 255u) == 0u) { if (xb_ld(&bar[XB_TMO])) break; if (sp > XB_SPIN_CAP) { atomicAdd(&bar[XB_TMO], 1u); break; } }
  }
  nloc = mine > 0u ? mine : 1u; nx = cnt > 0u ? cnt : 1u;
}
DI void xcd_barrier(const XcdBarrier& b) {
  asm volatile("s_waitcnt vmcnt(0)" ::: "memory");
  __syncthreads();
  if (threadIdx.x == 0) {
    unsigned* bar = b.bar;
    __builtin_amdgcn_s_waitcnt(0);
    unsigned nloc = b.st[0], nx = b.st[1];
    if (nloc == 0u) { xcd_barrier_complete(bar, b.x, nloc, nx); b.st[0] = nloc; b.st[1] = nx; }
    const unsigned old = xb_add(&bar[XB_XSUB(b.x)], 1u);
    const unsigned gen = old / nloc;
    if (old + 1u == (gen + 1u) * nloc) {
      __builtin_amdgcn_fence(__ATOMIC_RELEASE, "agent");
      asm volatile("s_waitcnt vmcnt(0)" ::: "memory");
      const unsigned og = xb_add(&bar[XB_TOP], 1u);
      const unsigned tg = og / nx;
      if (og + 1u == (tg + 1u) * nx) xb_add(&bar[XB_TOPGEN], 1u);
      else XB_SPIN(xb_ld(&bar[XB_TOPGEN]) == tg, bar);
      __builtin_amdgcn_fence(__ATOMIC_ACQUIRE, "agent");
      xb_add(&bar[XB_XGEN(b.x)], 1u);
      asm volatile("s_waitcnt vmcnt(0)" ::: "memory");
    } else {
      XB_SPIN(xb_ld(&bar[XB_XGEN(b.x)]) == gen, bar);
      __builtin_amdgcn_fence(__ATOMIC_ACQUIRE, "agent");
      asm volatile("s_waitcnt vmcnt(0)" ::: "memory");
    }
  }
  __syncthreads();
}
constexpr size_t WS_BAR = WS_CTL + 4096;
constexpr size_t WS_TS  = WS_CTL + 32768;
#ifndef USE_CG_SYNC
#define USE_CG_SYNC 0
#endif
#ifndef DBL_PHASE
#define DBL_PHASE -1
#endif
#define RUNP(idx, call) do { _Pragma("nounroll") for (int rep_ = 0; rep_ < launder_s(DBL_PHASE == (idx) ? 2 : 1); ++rep_) { call; } } while (0)
constexpr int ATT_LDS_ALL = ATT_LDS + 8 * 12 * 64 * 16;
constexpr int DYN_LDS = ATT_LDS_ALL;
static_assert(DYN_LDS >= GEMM_LDS && DYN_LDS >= SCAN_LDS && DYN_LDS <= 160 * 1024 - 512, "LDS budget");
__global__ void __launch_bounds__(NTHR) k_mega(Params pa) {
  cg::grid_group grid = cg::this_grid();
  extern __shared__ __attribute__((aligned(16))) unsigned char smem[];
  __shared__ uint4 xb_words;
  if (threadIdx.x < 35) s_ptr[threadIdx.x] = (unsigned long long)pa.in[threadIdx.x];
  if (threadIdx.x == 0) { xb_words = make_uint4(0u, 0u, 0u, 0u); s_tc[0] = 0; s_tc[1] = 0; }
  __syncthreads();
  PT p; p.out = pa.out; p.ws = pa.ws;
  const XcdBarrier xbar = xcd_barrier_post((unsigned*)(pa.ws + WS_BAR), (volatile LAS unsigned*)&xb_words);
  unsigned long long* ts = (unsigned long long*)(pa.ws + WS_TS);
  int nts = 0;
#define STAMP() do { if (PROBE_PHASE >= 0 && blockIdx.x == 0 && threadIdx.x == 0) ts[nts] = __builtin_amdgcn_s_memrealtime(); ++nts; } while (0)
#define GSYNC() do { if (USE_CG_SYNC) grid.sync(); else xcd_barrier(xbar); STAMP(); } while (0)
  STAMP();
  ph_mod2(p, smem);
  xcd_barrier(xbar);
  STAMP();
#pragma nounroll
  for (int l = 0; l < DEPTH; ++l) {
    if (l == 0) { RUNP(1, ph_prenorm_v(p, l)); GSYNC(); }
    RUNP(2, ph_gemm1(p, l, smem));        GSYNC();
    RUNP(3, ph_mla_lora(p, l, smem));     GSYNC();
    unsigned long long ck0_ = 0, rk0_ = 0;
    if (PROBE_PHASE == 70 && blockIdx.x == 0 && threadIdx.x == 0) { ck0_ = __builtin_amdgcn_s_memtime(); rk0_ = __builtin_amdgcn_s_memrealtime(); }
    ph_p4_scan(p, l, smem);               STAMP();
    if (PROBE_PHASE == 70 && blockIdx.x == 0 && threadIdx.x == 0 && l == 0) { const unsigned long long ck1_ = __builtin_amdgcn_s_memtime(), rk1_ = __builtin_amdgcn_s_memrealtime(); s_tc[0] = (ck1_ - ck0_) * 1000ull / (rk1_ - rk0_); }
    ph_p4_queue(p, l, smem);              STAMP(); GSYNC();
    RUNP(7, ph_rwkvout_v(p, l));          GSYNC();
    RUNP(8, ph_wout(p, l, smem));         GSYNC();
    ph_postmix_v(p, l, smem);             GSYNC();
    RUNP(10, ph_moe_up(p, l, smem));      GSYNC();
    RUNP(11, ph_moe_down(p, l, smem));    GSYNC();
    ph_postffn_v(p, l);                   if (l + 1 < DEPTH || PROBE_PHASE >= 0) GSYNC();
    if (DBL_PHASE == 20) { for (int q_ = 0; q_ < 10; ++q_) GSYNC(); }
  }
  if (PROBE_PHASE >= 0 && blockIdx.x == 0 && threadIdx.x == 0) {
    unsigned long long t = 0;
    const int k = PROBE_PHASE;
    if (k == 70) t = s_tc[0];
    else if (k >= 50) t = s_tc[k - 50];
    else if (k == 0) t = ts[1] - ts[0];
    else { t = ts[1 + k] - ts[k]; if (k >= 2) t += ts[12 + k] - ts[11 + k]; }
    const unsigned long long t0 = __builtin_amdgcn_s_memrealtime();
    while (__builtin_amdgcn_s_memrealtime() - t0 < t) __builtin_amdgcn_s_sleep(8);
  }
}

extern "C" void kernel_launch(void* const* d_in, const int* in_sizes, int n_in, void* d_out, int out_size, void* d_ws, size_t ws_size,
                              hipStream_t stream) {
  static int grid_blocks = 0;
  if (!grid_blocks) {
    int dev = 0, cus = 0, per_cu = 0;
    (void)hipGetDevice(&dev);
    (void)hipDeviceGetAttribute(&cus, hipDeviceAttributeMultiprocessorCount, dev);
    (void)hipFuncSetAttribute((const void*)k_mega, hipFuncAttributeMaxDynamicSharedMemorySize, DYN_LDS);
    (void)hipOccupancyMaxActiveBlocksPerMultiprocessor(&per_cu, (const void*)k_mega, NTHR, DYN_LDS);
    if (per_cu < 1) per_cu = 1;
    grid_blocks = cus;
    if (ws_size < WS_END) fprintf(stderr, "kernel_launch: workspace too small: %zu < %zu\n", ws_size, (size_t)WS_END);
  }
  Params p{};
  for (int i = 0; i < 35; ++i) p.in[i] = (const float*)d_in[i];
  p.out = (float*)d_out; p.ws = (unsigned char*)d_ws;
  (void)hipMemsetAsync((char*)d_ws + WS_CTL, 0, 65536, stream);
  void* args[] = {&p};
  hipError_t e = hipLaunchCooperativeKernel((const void*)k_mega, dim3(grid_blocks), dim3(NTHR), args, DYN_LDS, stream);
  if (e != hipSuccess) fprintf(stderr, "cooperative launch failed: %s (grid %d)\n", hipGetErrorString(e), grid_blocks);
}
```
